# Optimizing an MI355X kernel written in HIP

```python
import math
import jax, jax.numpy as jnp
from jax import lax
import numpy as np

D_MODEL = 1024
BATCH = 8
SEQ = 2048
DEPTH = 2

EPS = 1e-6
RET_HEADS = 4
RET_QK_DIM = 128
RET_V_DIM = 128
RET_WIDTH = RET_HEADS * RET_V_DIM
RET_CHUNK = 128
ROPE_THETA = 10000.0
SSM_WIDTH = D_MODEL
SSM_HEAD_DIM = 64
SSM_HEADS = SSM_WIDTH // SSM_HEAD_DIM
SSM_GROUPS = 2
SSM_STATE = 128
SSM_CONV = 4
SSM_CHUNK = 128
SSM_XBC = SSM_WIDTH + 2 * SSM_GROUPS * SSM_STATE
SC_WIDTH = D_MODEL // 2
SC_CONV = 3
N_BRANCH = 3

IN_SIZES = (
    RET_HEADS * RET_QK_DIM,
    RET_HEADS * RET_QK_DIM,
    RET_WIDTH,
    RET_WIDTH,
    SSM_WIDTH,
    SSM_XBC,
    SSM_HEADS,
    SC_WIDTH,
    SC_WIDTH,
    SC_WIDTH,
    SC_WIDTH,
    N_BRANCH * D_MODEL,
)
IN_WIDTH = sum(IN_SIZES)

kernel_name = "hybrid_retention_ssd_shortconv_gated_merge"


def rms_norm(x, g):
    xf = x.astype(jnp.float32)
    y = xf * lax.rsqrt(jnp.mean(xf * xf, axis=-1, keepdims=True) + EPS)
    return (y * g.astype(jnp.float32)).astype(x.dtype)


def causal_depthwise_conv(u, w):
    K = w.shape[0]
    L = u.shape[1]
    up = jnp.pad(u, ((0, 0), (K - 1, 0), (0, 0)))
    return sum(up[:, k:k + L] * w[k] for k in range(K))


def rotary(x, pos):
    dh = x.shape[-1]
    inv_freq = ROPE_THETA ** (-jnp.arange(0, dh, 2, dtype=jnp.float32) / dh)
    ang = pos.astype(jnp.float32)[..., None] * inv_freq
    cos = jnp.cos(ang)[:, :, None, :]
    sin = jnp.sin(ang)[:, :, None, :]
    x1, x2 = jnp.split(x, 2, axis=-1)
    return jnp.concatenate([x1 * cos - x2 * sin, x1 * sin + x2 * cos], axis=-1)


def chunkwise_retention(q, k, v):
    Bsz, L, H, dk = q.shape
    dv = v.shape[-1]
    C = RET_CHUNK
    n = L // C
    gamma = 1.0 - jnp.exp2(-5.0 - jnp.arange(H, dtype=jnp.float32))
    log_g = jnp.log(gamma)
    idx = jnp.arange(C, dtype=jnp.float32)
    diff = idx[:, None] - idx[None, :]
    decay_mask = jnp.exp(jnp.where(diff[None] >= 0, diff[None] * log_g[:, None, None], -jnp.inf))
    k_decay = jnp.exp((C - 1 - idx)[None, :] * log_g[:, None])
    q_decay = jnp.exp((idx + 1)[None, :] * log_g[:, None])
    chunk_decay = jnp.exp(C * log_g)

    def to_chunks(t):
        return t.reshape(Bsz, n, C, H, t.shape[-1]).transpose(1, 0, 3, 2, 4)

    qc, kc, vc = to_chunks(q), to_chunks(k), to_chunks(v)
    scores = jnp.einsum('nbhid,nbhjd->nbhij', qc, kc) * decay_mask[None, None]
    inner = jnp.einsum('nbhij,nbhje->nbhie', scores, vc)
    kv = jnp.einsum('nbhjd,hj,nbhje->nbhde', kc, k_decay, vc)

    def step(state, kv_n):
        return chunk_decay[None, :, None, None] * state + kv_n, state

    _, prev = lax.scan(step, jnp.zeros((Bsz, H, dk, dv), jnp.float32), kv)
    cross = jnp.einsum('nbhid,nbhde->nbhie', qc, prev) * q_decay[None, None, :, :, None]
    out = (inner + cross).transpose(1, 0, 3, 2, 4)
    return out.reshape(Bsz, L, H, dv)


def ssd_chunked(x, dt, A, Bm, Cm):
    b, l, h, p = x.shape
    g, nst = Bm.shape[-2], Bm.shape[-1]
    hg = h // g
    CH = SSM_CHUNK
    nc = l // CH
    xc = x.reshape(b, nc, CH, g, hg, p)
    dtc = dt.reshape(b, nc, CH, g, hg)
    Bc = Bm.reshape(b, nc, CH, g, nst)
    Cc = Cm.reshape(b, nc, CH, g, nst)
    a = (dtc * A.reshape(g, hg)).transpose(0, 3, 4, 1, 2)
    a_cs = jnp.cumsum(a, axis=-1)
    seg = a_cs[..., :, None] - a_cs[..., None, :]
    tril = jnp.tril(jnp.ones((CH, CH), dtype=bool))
    Lm = jnp.exp(jnp.where(tril, seg, -jnp.inf))
    xdt = xc * dtc[..., None]
    y_diag = jnp.einsum('bclgn,bcsgn,bghcls,bcsghp->bclghp', Cc, Bc, Lm, xdt)
    decay_states = jnp.exp(a_cs[..., -1:] - a_cs)
    states = jnp.einsum('bclgn,bghcl,bclghp->bcghpn', Bc, decay_states, xdt)
    chunk_decay = jnp.exp(a_cs[..., -1])

    def step(hstate, inp):
        s, d = inp
        return d[..., None, None] * hstate + s, hstate

    _, prev = lax.scan(step, jnp.zeros((b, g, hg, p, nst), jnp.float32),
                       (jnp.moveaxis(states, 1, 0), jnp.moveaxis(chunk_decay, 3, 0)))
    prev = jnp.moveaxis(prev, 0, 1)
    y_off = jnp.einsum('bclgn,bcghpn,bghcl->bclghp', Cc, prev, jnp.exp(a_cs))
    return (y_diag + y_off).reshape(b, l, h, p)


def retention_branch(q, k, v, gate, positions):
    Bsz, L, _ = q.shape
    f32 = jnp.float32
    qh = rotary(q.astype(f32).reshape(Bsz, L, RET_HEADS, RET_QK_DIM), positions) * (RET_QK_DIM ** -0.5)
    kh = rotary(k.astype(f32).reshape(Bsz, L, RET_HEADS, RET_QK_DIM), positions)
    vh = v.astype(f32).reshape(Bsz, L, RET_HEADS, RET_V_DIM)
    o = chunkwise_retention(qh, kh, vh)
    mu = jnp.mean(o, axis=-1, keepdims=True)
    var = jnp.mean(jnp.square(o - mu), axis=-1, keepdims=True)
    o = ((o - mu) * lax.rsqrt(var + EPS)).reshape(Bsz, L, RET_WIDTH)
    return (o * jax.nn.silu(gate.astype(f32))).astype(q.dtype)


def ssd_branch(z, xbc, dt_raw, conv_w, conv_b, dt_bias, a_log, d_skip, norm_g):
    Bsz, L, _ = z.shape
    f32 = jnp.float32
    xbc = jax.nn.silu(causal_depthwise_conv(xbc, conv_w) + conv_b)
    xs, Bm, Cm = jnp.split(xbc, [SSM_WIDTH, SSM_WIDTH + SSM_GROUPS * SSM_STATE], axis=-1)
    xs = xs.astype(f32).reshape(Bsz, L, SSM_HEADS, SSM_HEAD_DIM)
    Bm = Bm.astype(f32).reshape(Bsz, L, SSM_GROUPS, SSM_STATE)
    Cm = Cm.astype(f32).reshape(Bsz, L, SSM_GROUPS, SSM_STATE)
    dt = jax.nn.softplus(dt_raw.astype(f32) + dt_bias.astype(f32))
    A = -jnp.exp(a_log.astype(f32))
    y = ssd_chunked(xs, dt, A, Bm, Cm) + d_skip.astype(f32)[:, None] * xs
    y = y.reshape(Bsz, L, SSM_WIDTH) * jax.nn.silu(z.astype(f32))
    return rms_norm(y, norm_g).astype(z.dtype)


def short_conv_branch(bg, cg, hv, gate, conv_w):
    u = cg * hv
    return bg * causal_depthwise_conv(u, conv_w) * jax.nn.silu(gate)


def setup_inputs(seed: int = 0) -> dict:
    key = jax.random.key(seed)
    ks = jax.random.split(key, 24)
    D = D_MODEL
    nrm = jax.random.normal
    dt0 = jnp.exp(jax.random.uniform(ks[8], (DEPTH, SSM_HEADS)) * (math.log(0.1) - math.log(0.001)) + math.log(0.001))
    return {
        "x": nrm(ks[0], (BATCH, SEQ, D), jnp.float32),
        "c": nrm(ks[1], (BATCH, D), jnp.float32),
        "positions": (jnp.arange(SEQ, dtype=jnp.int32)[None, :]
                      + jax.random.randint(ks[2], (BATCH, 1), 0, 1024, dtype=jnp.int32)),
        "norm_g": 1.0 + 0.02 * nrm(ks[3], (DEPTH, D)),
        "w_ada": nrm(ks[4], (DEPTH, D, 3 * D)) * (0.5 * D ** -0.5),
        "b_ada": 0.02 * nrm(ks[5], (DEPTH, 3 * D)),
        "w_in": nrm(ks[6], (DEPTH, D, IN_WIDTH)) * D ** -0.5,
        "ssm_conv_w": nrm(ks[7], (DEPTH, SSM_CONV, SSM_XBC)) * SSM_CONV ** -0.5,
        "ssm_conv_b": 0.02 * nrm(ks[9], (DEPTH, SSM_XBC)),
        "ssm_dt_bias": dt0 + jnp.log(-jnp.expm1(-dt0)),
        "ssm_a_log": jnp.log(jax.random.uniform(ks[10], (DEPTH, SSM_HEADS), minval=1.0, maxval=16.0)),
        "ssm_d": 1.0 + 0.02 * nrm(ks[11], (DEPTH, SSM_HEADS)),
        "ssm_norm_g": 1.0 + 0.02 * nrm(ks[12], (DEPTH, SSM_WIDTH)),
        "sc_conv_w": nrm(ks[13], (DEPTH, SC_CONV, SC_WIDTH)) * SC_CONV ** -0.5,
        "w_br_ret": nrm(ks[14], (DEPTH, RET_WIDTH, D)) * RET_WIDTH ** -0.5,
        "w_br_ssm": nrm(ks[15], (DEPTH, SSM_WIDTH, D)) * SSM_WIDTH ** -0.5,
        "w_br_sc": nrm(ks[16], (DEPTH, SC_WIDTH, D)) * SC_WIDTH ** -0.5,
        "w_out": nrm(ks[17], (DEPTH, D, D)) * D ** -0.5,
        "final_norm_g": 1.0 + 0.02 * nrm(ks[18], (D,)),
    }


def reference(x, c, positions, norm_g, w_ada, b_ada, w_in, ssm_conv_w, ssm_conv_b, ssm_dt_bias,
              ssm_a_log, ssm_d, ssm_norm_g, sc_conv_w, w_br_ret, w_br_ssm, w_br_sc, w_out, final_norm_g):
    Bsz, L, D = x.shape
    split_idx = np.cumsum(IN_SIZES)[:-1].tolist()
    c_act = jax.nn.silu(c)
    for layer in range(DEPTH):
        ada = c_act @ w_ada[layer] + b_ada[layer]
        shift, scale, res_gate = jnp.split(ada, 3, axis=-1)
        h = rms_norm(x, norm_g[layer]) * (1.0 + scale[:, None]) + shift[:, None]
        proj = h @ w_in[layer]
        (r_q, r_k, r_v, r_g, s_z, s_xbc, s_dt,
         c_b, c_c, c_h, c_g, merge_logits) = jnp.split(proj, split_idx, axis=-1)
        y_ret = retention_branch(r_q, r_k, r_v, r_g, positions)
        y_ssm = ssd_branch(s_z, s_xbc, s_dt, ssm_conv_w[layer], ssm_conv_b[layer], ssm_dt_bias[layer],
                           ssm_a_log[layer], ssm_d[layer], ssm_norm_g[layer])
        y_sc = short_conv_branch(c_b, c_c, c_h, c_g, sc_conv_w[layer])
        gates = jax.nn.sigmoid(merge_logits).reshape(Bsz, L, N_BRANCH, D)
        merged = (gates[:, :, 0] * (y_ret @ w_br_ret[layer])
                  + gates[:, :, 1] * (y_ssm @ w_br_ssm[layer])
                  + gates[:, :, 2] * (y_sc @ w_br_sc[layer]))
        out = merged @ w_out[layer]
        x = x + res_gate[:, None] * out
    return rms_norm(x, final_norm_g)
```

```cpp
#include <hip/hip_runtime.h>
#include <cstdio>
#include <cstdint>

#ifndef MK_SPLIT
#define MK_SPLIT 0
#endif
#ifndef MK_OFF
#define MK_OFF 0
#endif
#ifndef MK_PH_HI
#define MK_PH_HI 1000
#endif

#define LAS __attribute__((address_space(3)))
#define GAS __attribute__((address_space(1)))
typedef unsigned short bf16_t;
typedef short bf16x8 __attribute__((ext_vector_type(8)));
typedef float f32x4 __attribute__((ext_vector_type(4)));
typedef float f32x2 __attribute__((ext_vector_type(2)));
typedef unsigned u32x4 __attribute__((ext_vector_type(4)));
typedef unsigned u32x2 __attribute__((ext_vector_type(2)));

constexpr int BATCH = 8, SEQ = 2048, D = 1024, T = BATCH * SEQ, DEPTH = 2;
constexpr int IN_W = 9744;
constexpr int C_RQ = 0, C_RK = 512, C_RV = 1024, C_RG = 1536, C_SZ = 2048, C_XBC = 3072, C_DT = 4608, C_CB = 4624, C_CC = 5136, C_CH = 5648, C_CG = 6160, C_MG = 6672;
constexpr int NA = 5632;
constexpr int PA_Q = 0, PA_K = 512, PA_V = 1024, PA_G = 1536, PA_Z = 2048, PA_XBC = 3072, PA_U = 4608, PA_W = 5120;
constexpr int N1A = 26 * 256, N1B = 12 * 256, NW1 = N1A + N1B;
constexpr float EPS = 1e-6f;

constexpr size_t WS_CTL = 0, CTL_BYTES = 1u << 20;
constexpr size_t WS_ADA = WS_CTL + CTL_BYTES;
constexpr size_t WS_CS = WS_ADA + (size_t)2 * 8 * 3072 * 4;
constexpr size_t WS_DT = WS_CS + (size_t)T * 64 * 2 * 4;
constexpr size_t WS_SSQ = WS_DT + (size_t)T * 16 * 4;
constexpr size_t WS_WIN = WS_SSQ + (size_t)T * 16 * 4;
constexpr size_t WS_WBR = WS_WIN + (size_t)NW1 * 1024 * 2;
constexpr size_t WS_WOUT = WS_WBR + (size_t)1024 * 2048 * 2;
constexpr size_t WS_H = WS_WOUT + (size_t)1024 * 1024 * 2;
constexpr size_t WS_PA = WS_H + (size_t)T * 1024 * 2;
constexpr size_t WS_END = WS_PA + (size_t)T * NA * 2;
static_assert(WS_END <= 319291392ull, "workspace");

constexpr int CW_BAR = 4096;

constexpr int RING_BYTES = 131072;
constexpr int MISC_OFF = RING_BYTES + 320;
constexpr int LDS_BYTES = 147456;

#define LDS_WAIT() asm volatile("s_waitcnt lgkmcnt(0)" ::: "memory")
#define VM_WAIT() asm volatile("s_waitcnt vmcnt(0)" ::: "memory")
__device__ __forceinline__ unsigned f2bf(float f) { unsigned u = __builtin_bit_cast(unsigned, f); return (u + 0x7fffu + ((u >> 16) & 1u)) >> 16; }
__device__ __forceinline__ unsigned pk2(float lo, float hi) { return f2bf(lo) | (f2bf(hi) << 16); }
__device__ __forceinline__ float bf2f(unsigned short b) { return __builtin_bit_cast(float, ((unsigned)b) << 16); }
__device__ __forceinline__ float bflo(unsigned w) { return __builtin_bit_cast(float, w << 16); }
__device__ __forceinline__ float bfhi(unsigned w) { return __builtin_bit_cast(float, w & 0xffff0000u); }
#define SWZ_XOR(v, m) __builtin_bit_cast(float, __builtin_amdgcn_ds_swizzle(__builtin_bit_cast(int, (v)), (((m) << 10) | 0x1f)))
__device__ __forceinline__ float wave_sum(float v) {
    v += SWZ_XOR(v, 1); v += SWZ_XOR(v, 2); v += SWZ_XOR(v, 4); v += SWZ_XOR(v, 8); v += SWZ_XOR(v, 16);
    return __builtin_bit_cast(float, __builtin_amdgcn_readlane(__builtin_bit_cast(int, v), 0)) + __builtin_bit_cast(float, __builtin_amdgcn_readlane(__builtin_bit_cast(int, v), 32));
}
__device__ __forceinline__ float silu_f(float x) { return x / (1.0f + __expf(-x)); }

#define XB_TMO      128
#define XB_XCNT(j)  (256  + 64 * (j))
#define XB_XSUB(j)  (1280 + 64 * (j))
#define XB_XGEN(j)  (2304 + 64 * (j))
#define XB_TOP      3328
#define XB_TOPGEN   3392
#define XCD_BAR_WORDS 3456
#define XB_SPIN_CAP (1u << 18)
__device__ __forceinline__ unsigned xb_ld(unsigned* p)              { return __hip_atomic_load(p, __ATOMIC_RELAXED, __HIP_MEMORY_SCOPE_AGENT); }
__device__ __forceinline__ unsigned xb_add(unsigned* p, unsigned v) { return __hip_atomic_fetch_add(p, v, __ATOMIC_RELAXED, __HIP_MEMORY_SCOPE_AGENT); }
__device__ __forceinline__ unsigned xb_xcc_id() { return (unsigned)__builtin_amdgcn_s_getreg((3 << 11) | 20) & 0xFu; }
#define XB_SPIN(cond, bar) do { unsigned _sp = 0; while (cond) { __builtin_amdgcn_s_sleep(1); \
    if ((++_sp & 255u) == 0u) { if (xb_ld(&(bar)[XB_TMO])) break; if (_sp > XB_SPIN_CAP) { atomicAdd(&(bar)[XB_TMO], 1u); break; } } } } while (0)
struct XcdBarrier { unsigned* bar; unsigned x; volatile LAS unsigned* st; };
__device__ __forceinline__ XcdBarrier xcd_barrier_post(unsigned* bar, volatile LAS unsigned* st) {
    XcdBarrier b; b.bar = bar; b.x = xb_xcc_id(); b.st = st;
    if (threadIdx.x == 0) (void)xb_add(&bar[XB_XCNT(b.x)], 1u);
    return b;
}
__device__ __forceinline__ void xcd_barrier_complete(unsigned* bar, unsigned x, unsigned& nloc, unsigned& nx) {
    const unsigned G = gridDim.x * gridDim.y * gridDim.z;
    unsigned sum, cnt, mine, sp = 0u;
    for (;;) {
        sum = 0u; cnt = 0u; mine = 0u;
#pragma unroll 1
        for (unsigned j = 0; j < 16; ++j) { const unsigned c = xb_ld(&bar[XB_XCNT(j)]); sum += c; cnt += (c > 0u) ? 1u : 0u; mine = (j == x) ? c : mine; }
        if (sum == G) break;
        __builtin_amdgcn_s_sleep(1);
        if ((++sp & 255u) == 0u) { if (xb_ld(&bar[XB_TMO])) break; if (sp > XB_SPIN_CAP) { atomicAdd(&bar[XB_TMO], 1u); break; } }
    }
    nloc = mine > 0u ? mine : 1u; nx = cnt > 0u ? cnt : 1u;
}
__device__ __forceinline__ void xcd_barrier(const XcdBarrier& b) {
    asm volatile("s_waitcnt vmcnt(0)" ::: "memory");
    __syncthreads();
    if (threadIdx.x == 0) {
        unsigned* bar = b.bar;
        __builtin_amdgcn_s_waitcnt(0);
        unsigned nloc = b.st[0], nx = b.st[1];
        if (nloc == 0u) { xcd_barrier_complete(bar, b.x, nloc, nx); b.st[0] = nloc; b.st[1] = nx; }
        const unsigned old = xb_add(&bar[XB_XSUB(b.x)], 1u);
        const unsigned gen = old / nloc;
        if (old + 1u == (gen + 1u) * nloc) {
            __builtin_amdgcn_fence(__ATOMIC_RELEASE, "agent");
            asm volatile("s_waitcnt vmcnt(0)" ::: "memory");
            const unsigned og = xb_add(&bar[XB_TOP], 1u);
            const unsigned tg = og / nx;
            if (og + 1u == (tg + 1u) * nx) xb_add(&bar[XB_TOPGEN], 1u);
            else XB_SPIN(xb_ld(&bar[XB_TOPGEN]) == tg, bar);
            __builtin_amdgcn_fence(__ATOMIC_ACQUIRE, "agent");
            xb_add(&bar[XB_XGEN(b.x)], 1u);
            asm volatile("s_waitcnt vmcnt(0)" ::: "memory");
        } else {
            XB_SPIN(xb_ld(&bar[XB_XGEN(b.x)]) == gen, bar);
            __builtin_amdgcn_fence(__ATOMIC_ACQUIRE, "agent");
            asm volatile("s_waitcnt vmcnt(0)" ::: "memory");
        }
    }
    __syncthreads();
}

namespace pg8 {
constexpr int BM = 256, BK = 64, HALF = 128, HTB = HALF * BK * 2, STAGE_BYTES = 8 * HTB, NXCD = 8, WGM = 8;
__host__ __device__ __forceinline__ int lds_byte(int r, int c) { const int st = (r >> 4) * 2 + (c >> 5), rr = r & 15, cc = c & 31, ob = rr * 64 + cc * 2; return st * 1024 + (ob ^ (((ob >> 9) & 1) << 5)); }
__host__ __device__ __forceinline__ void stage_rc(int b, int& R, int& C) { const int st = b / 1024, sb = b % 1024, swz = sb ^ (((sb >> 9) & 1) << 5); R = (st >> 1) * 16 + swz / 64; C = (st & 1) * 32 + (swz % 64) / 2; }
__host__ __device__ __forceinline__ int perm32(int rho) { const int n = rho >> 4, i = rho & 15; return 8 * (i >> 2) + 4 * n + (i & 3); }
struct Unit { int pm, pn; };
struct Gemm { const bf16_t* A; int lda; const bf16_t* Bt; int M, N, K; };
struct StaticOrder {
    int nM, nN, nwg, G, c;
    __device__ void init(int M, int N, int G_, int c_) { nM = M / BM; nN = N / BM; nwg = nM * nN; G = G_; c = c_; }
    __device__ bool next(int i, Unit& u) const {
        const long L = (long)i * G + c; if (L >= nwg) return false;
        int wgid = (int)L; { const int q = nwg / NXCD, r = nwg % NXCD, xcd = wgid % NXCD, off = wgid / NXCD; wgid = (xcd < r ? xcd * (q + 1) : r * (q + 1) + (xcd - r) * q) + off; }
        const int nig = WGM * nN, gid = wgid / nig, fm = gid * WGM, gsz = (nM - fm) < WGM ? (nM - fm) : WGM;
        u.pm = fm + ((wgid % nig) % gsz); u.pn = (wgid % nig) / gsz; return true;
    }
};
__device__ __forceinline__ unsigned cvt_pk_bf16(float lo, float hi) { unsigned r; asm volatile("v_cvt_pk_bf16_f32 %0, %1, %2" : "=v"(r) : "v"(lo), "v"(hi)); return r; }

struct AMapLinear { static constexpr int NSEG = 1; __device__ __forceinline__ int seg_end(int, int nt) const { return nt; } __device__ __forceinline__ size_t koff(int t) const { return (size_t)t * (BK * 2); } };
struct AMapBranch { static constexpr int NSEG = 3; __device__ __forceinline__ int seg_end(int sg, int) const { return sg == 0 ? 16 : (sg == 1 ? 24 : 32); } __device__ __forceinline__ size_t koff(int t) const { const int col = t < 16 ? PA_Z + 64 * t : (t < 24 ? PA_G + 64 * (t - 16) : PA_W + 64 * (t - 24)); return (size_t)col * 2; } };

template <class Epi, class AMap>
__device__ __forceinline__ void gemm_phase(LAS unsigned char* lds, const Gemm g, const StaticOrder& S, const Epi& E, const AMap AM) {
    int tid = threadIdx.x; asm volatile("" : "+v"(tid));
    const int wid = __builtin_amdgcn_readfirstlane(tid >> 6), lane = tid & 63, wr = wid >> 2, wc = wid & 3, fr = lane & 15, fq = lane >> 4;
    const int K = g.K, nt = K / BK;
    unsigned voffA[2], voffB[2];
#pragma unroll
    for (int i = 0; i < 2; ++i) { int R, C; stage_rc(tid * 16 + i * 8192, R, C); const int Rb = Epi::PERM ? ((R & ~31) + perm32(R & 31)) : R;
        voffA[i] = (unsigned)(R * g.lda + C) * 2u; voffB[i] = (unsigned)(Rb * K + C) * 2u; }
    const size_t kstep = (size_t)(BK * 2);
    const size_t hstepA = (size_t)HALF * g.lda * 2, hstepB = (size_t)HALF * K * 2;
    const size_t tstepA = 2 * hstepA, tstepB = 2 * hstepB;
    const unsigned ldsw = (unsigned)wid * 1024u;
    const int aoff = lds_byte(wr * 64 + fr, fq * 8), boff = lds_byte(wc * 32 + fr, fq * 8);
#define PG8_SA(b, h) (((b) * 2 + (h)) * HTB)
#define PG8_SB(b, h) ((4 + (b) * 2 + (h)) * HTB)
#define PG8_STAGE(bufoff, gbase, voff) do { _Pragma("unroll") for (int _i = 0; _i < 2; ++_i) \
        __builtin_amdgcn_global_load_lds((const unsigned*)((const char*)(gbase) + (voff)[_i]), (LAS unsigned*)(lds + (bufoff) + ldsw + _i * 8192), 16, 0, 0); } while (0)
#define PG8_LDA(dst, b, h) do { _Pragma("unroll") for (int m = 0; m < 4; ++m) _Pragma("unroll") for (int k = 0; k < 2; ++k) dst[m][k] = *(const LAS bf16x8*)(lds + PG8_SA(b, h) + aoff + m * 2048 + k * 1024); } while (0)
#define PG8_LDB(dst, b, h) do { _Pragma("unroll") for (int n = 0; n < 2; ++n) _Pragma("unroll") for (int k = 0; k < 2; ++k) dst[n][k] = *(const LAS bf16x8*)(lds + PG8_SB(b, h) + boff + n * 2048 + k * 1024); } while (0)
#define PG8_MMA(ai, bj, At, Bt) do { __builtin_amdgcn_s_setprio(1); _Pragma("unroll") for (int m = 0; m < 4; ++m) _Pragma("unroll") for (int n = 0; n < 2; ++n) _Pragma("unroll") for (int k = 0; k < 2; ++k) \
        acc[ai][bj][m][n] = __builtin_amdgcn_mfma_f32_16x16x32_bf16(Bt[n][k], At[m][k], acc[ai][bj][m][n], 0, 0, 0); __builtin_amdgcn_s_setprio(0); } while (0)
#define PG8_WAIT_V(n) asm volatile("s_waitcnt vmcnt(" #n ")" ::: "memory")
#define PG8_WAIT_L(n) asm volatile("s_waitcnt lgkmcnt(" #n ")" ::: "memory")
#define PG8_BAR __builtin_amdgcn_s_barrier()
#define PG8_SCHED __builtin_amdgcn_sched_barrier(0)
    Unit cur, nxt; int ui = 0;
    if (!S.next(0, cur)) return;
    f32x4 acc[2][2][4][2];
#pragma unroll
    for (int a = 0; a < 2; ++a)
#pragma unroll
        for (int b = 0; b < 2; ++b)
#pragma unroll
            for (int m = 0; m < 4; ++m)
#pragma unroll
                for (int n = 0; n < 2; ++n) acc[a][b][m][n] = (f32x4){0.f, 0.f, 0.f, 0.f};
    bf16x8 At[4][2], B0[2][2], B1[2][2];
    const char* cAb = (const char*)g.A + (size_t)cur.pm * tstepA;
    const char* cB = (const char*)g.Bt + (size_t)cur.pn * tstepB;
    {
        const char* cA = cAb + AM.koff(0);
        PG8_STAGE(PG8_SB(0, 0), cB, voffB); PG8_STAGE(PG8_SA(0, 0), cA, voffA); PG8_STAGE(PG8_SB(0, 1), cB + hstepB, voffB); PG8_STAGE(PG8_SA(0, 1), cA + hstepA, voffA);
        if (wr == 1) PG8_BAR;
        PG8_WAIT_V(4); PG8_BAR;
        PG8_STAGE(PG8_SB(1, 0), cB + kstep, voffB); PG8_STAGE(PG8_SA(1, 0), cA + kstep, voffA); PG8_STAGE(PG8_SB(1, 1), cB + hstepB + kstep, voffB);
        PG8_WAIT_V(6); PG8_BAR;
    }
    for (;;) {
        const bool has_next = S.next(ui + 1, nxt);
        const char* nAb = has_next ? (const char*)g.A + (size_t)nxt.pm * tstepA : cAb; const char* nB = has_next ? (const char*)g.Bt + (size_t)nxt.pn * tstepB : cB;
        int t = 0;
#pragma unroll 1
        for (int sg = 0; sg < AMap::NSEG; ++sg) {
        const int te = AM.seg_end(sg, nt);
#pragma unroll 1
        for (; t < te; t += 2) {
            const bool last = (t == nt - 2);
            const char* a1 = cAb + AM.koff(t + 1);
            const char* a2 = last ? nAb + AM.koff(0) : cAb + AM.koff(t + 2); const char* b2 = last ? nB : cB + (size_t)(t + 2) * kstep;
            const char* a3 = a2 + kstep; const char* b3 = b2 + kstep;
            PG8_LDB(B0, 0, 0); PG8_SCHED; PG8_LDA(At, 0, 0); PG8_STAGE(PG8_SA(1, 1), a1 + hstepA, voffA);
            PG8_WAIT_L(8); PG8_BAR; PG8_WAIT_L(0); PG8_MMA(0, 0, At, B0); PG8_BAR; PG8_SCHED;
            PG8_LDB(B1, 0, 1); PG8_STAGE(PG8_SB(0, 0), b2, voffB);
            PG8_BAR; PG8_WAIT_L(0); PG8_MMA(0, 1, At, B1); PG8_BAR;
            PG8_LDA(At, 0, 1); PG8_STAGE(PG8_SA(0, 0), a2, voffA);
            PG8_BAR; PG8_WAIT_L(0); PG8_MMA(1, 0, At, B0); PG8_BAR; PG8_SCHED;
            PG8_STAGE(PG8_SB(0, 1), b2 + hstepB, voffB);
            PG8_WAIT_V(6); PG8_BAR; PG8_MMA(1, 1, At, B1); PG8_BAR;
            PG8_LDB(B0, 1, 0); PG8_SCHED; PG8_LDA(At, 1, 0); PG8_STAGE(PG8_SA(0, 1), a2 + hstepA, voffA);
            PG8_WAIT_L(8); PG8_BAR; PG8_WAIT_L(0); PG8_MMA(0, 0, At, B0); PG8_BAR; PG8_SCHED;
            PG8_LDB(B1, 1, 1); PG8_STAGE(PG8_SB(1, 0), b3, voffB);
            PG8_BAR; PG8_WAIT_L(0); PG8_MMA(0, 1, At, B1); PG8_BAR;
            PG8_LDA(At, 1, 1); PG8_STAGE(PG8_SA(1, 0), a3, voffA);
            PG8_BAR; PG8_WAIT_L(0); PG8_MMA(1, 0, At, B0); PG8_BAR; PG8_SCHED;
            PG8_STAGE(PG8_SB(1, 1), b3 + hstepB, voffB);
            PG8_WAIT_V(6); PG8_BAR; PG8_MMA(1, 1, At, B1); PG8_BAR;
        }
        if (AMap::NSEG > 1 && sg + 1 < AMap::NSEG) E.mid(acc, cur, sg, wr, wc, fr, fq);
        }
        E(acc, cur, wr, wc, fr, fq);
        if (!has_next) break;
#pragma unroll
        for (int a = 0; a < 2; ++a)
#pragma unroll
            for (int b = 0; b < 2; ++b)
#pragma unroll
                for (int m = 0; m < 4; ++m)
#pragma unroll
                    for (int n = 0; n < 2; ++n) acc[a][b][m][n] = (f32x4){0.f, 0.f, 0.f, 0.f};
        cur = nxt; cAb = nAb; cB = nB; ++ui;
    }
    PG8_WAIT_V(0);
    if (wr == 0) PG8_BAR;
    PG8_BAR;
#undef PG8_SA
#undef PG8_SB
#undef PG8_STAGE
#undef PG8_LDA
#undef PG8_LDB
#undef PG8_MMA
#undef PG8_WAIT_V
#undef PG8_WAIT_L
#undef PG8_BAR
#undef PG8_SCHED
}
}
using pg8::cvt_pk_bf16;

struct EpiIn1 {
    static constexpr bool PERM = true;
    bf16_t* PA;
    __device__ __forceinline__ void mid(f32x4 (&)[2][2][4][2], const pg8::Unit&, int, int, int, int, int) const {}
    __device__ __forceinline__ void operator()(const f32x4 (&acc)[2][2][4][2], const pg8::Unit& u, int wr, int wc, int fr, int fq) const {
        int row0 = u.pm * 256 + wr * 64 + fr; asm volatile("" : "+v"(row0));
        if (u.pn < 18) {
            const int col0 = u.pn * 256 + wc * 32 + 8 * fq;
#pragma unroll
            for (int ai = 0; ai < 2; ++ai)
#pragma unroll
                for (int m = 0; m < 4; ++m) { bf16_t* rowp = PA + (size_t)(row0 + ai * 128 + m * 16) * NA + col0;
#pragma unroll
                    for (int bj = 0; bj < 2; ++bj) { const f32x4 v0 = acc[ai][bj][m][0], v1 = acc[ai][bj][m][1];
                        u32x4 w; w.x = cvt_pk_bf16(v0[0], v0[1]); w.y = cvt_pk_bf16(v0[2], v0[3]); w.z = cvt_pk_bf16(v1[0], v1[1]); w.w = cvt_pk_bf16(v1[2], v1[3]);
                        *(u32x4*)(rowp + bj * 128) = w; } }
        } else {
            const int ch0 = 64 * (u.pn - 18) + 16 * wc + 4 * fq;
#pragma unroll
            for (int ai = 0; ai < 2; ++ai)
#pragma unroll
                for (int m = 0; m < 4; ++m) { bf16_t* rowp = PA + (size_t)(row0 + ai * 128 + m * 16) * NA;
                    const f32x4 bg = acc[ai][0][m][0], cg = acc[ai][0][m][1], hv = acc[ai][1][m][0], gt = acc[ai][1][m][1];
                    f32x4 uu = cg * hv, ww;
#pragma unroll
                    for (int j = 0; j < 4; ++j) ww[j] = bg[j] * silu_f(gt[j]);
                    u32x2 pu, pw; pu.x = cvt_pk_bf16(uu[0], uu[1]); pu.y = cvt_pk_bf16(uu[2], uu[3]); pw.x = cvt_pk_bf16(ww[0], ww[1]); pw.y = cvt_pk_bf16(ww[2], ww[3]);
                    *(u32x2*)(rowp + PA_U + ch0) = pu; *(u32x2*)(rowp + PA_W + ch0) = pw; }
        }
    }
};
__device__ __forceinline__ int lg_col(int gate, int c) {
    return gate == 0 ? c : (gate == 1 ? PA_XBC + c : (c < 512 ? PA_V + c : PA_XBC + 1024 + (c - 512)));
}
struct EpiIn2 {
    static constexpr bool PERM = true;
    bf16_t* PA;
    __device__ __forceinline__ void mid(f32x4 (&)[2][2][4][2], const pg8::Unit&, int, int, int, int, int) const {}
    __device__ __forceinline__ void operator()(const f32x4 (&acc)[2][2][4][2], const pg8::Unit& u, int wr, int wc, int fr, int fq) const {
        int row0 = u.pm * 256 + wr * 64 + fr; asm volatile("" : "+v"(row0));
        const int gate = u.pn >> 2, cbase = (u.pn & 3) * 256;
#pragma unroll
        for (int ai = 0; ai < 2; ++ai)
#pragma unroll
            for (int m = 0; m < 4; ++m) { bf16_t* rowp = PA + (size_t)(row0 + ai * 128 + m * 16) * NA;
#pragma unroll
                for (int bj = 0; bj < 2; ++bj) { f32x4 v0 = acc[ai][bj][m][0], v1 = acc[ai][bj][m][1];
#pragma unroll
                    for (int j = 0; j < 4; ++j) { v0[j] = 1.0f + __expf(-fminf(fmaxf(v0[j], -30.f), 30.f)); v1[j] = 1.0f + __expf(-fminf(fmaxf(v1[j], -30.f), 30.f)); }
                    u32x4 w; w.x = cvt_pk_bf16(v0[0], v0[1]); w.y = cvt_pk_bf16(v0[2], v0[3]); w.z = cvt_pk_bf16(v1[0], v1[1]); w.w = cvt_pk_bf16(v1[2], v1[3]);
                    const int c = cbase + bj * 128 + wc * 32 + 8 * fq;
                    *(u32x4*)(rowp + lg_col(gate, c)) = w; } }
    }
};
struct EpiMerge {
    static constexpr bool PERM = true;
    const bf16_t* PA; const float* SSQ; bf16_t* MG;
    __device__ __forceinline__ void scale8(f32x4& v0, f32x4& v1, const bf16_t* num, const bf16_t* den, float rs) const {
        const u32x4 dn = *(const u32x4*)den;
        float d[8] = {bflo(dn.x), bfhi(dn.x), bflo(dn.y), bfhi(dn.y), bflo(dn.z), bfhi(dn.z), bflo(dn.w), bfhi(dn.w)};
        float nm[8];
        if (num) { const u32x4 nn = *(const u32x4*)num; nm[0] = bflo(nn.x); nm[1] = bfhi(nn.x); nm[2] = bflo(nn.y); nm[3] = bfhi(nn.y); nm[4] = bflo(nn.z); nm[5] = bfhi(nn.z); nm[6] = bflo(nn.w); nm[7] = bfhi(nn.w); }
        else {
#pragma unroll
            for (int j = 0; j < 8; ++j) nm[j] = 1.0f; }
#pragma unroll
        for (int j = 0; j < 4; ++j) { v0[j] *= rs * nm[j] * __builtin_amdgcn_rcpf(d[j]); v1[j] *= rs * nm[4 + j] * __builtin_amdgcn_rcpf(d[4 + j]); }
    }
    __device__ __forceinline__ void mid(f32x4 (&acc)[2][2][4][2], const pg8::Unit& u, int sg, int wr, int wc, int fr, int fq) const {
        int row0 = u.pm * 256 + wr * 64 + fr; asm volatile("" : "+v"(row0));
#pragma unroll
        for (int ai = 0; ai < 2; ++ai)
#pragma unroll
            for (int m = 0; m < 4; ++m) { const int row = row0 + ai * 128 + m * 16; const bf16_t* rowp = PA + (size_t)row * NA;
                float rs = 1.0f;
                if (sg == 0) { const f32x4* sp = (const f32x4*)(SSQ + (size_t)row * 16); const f32x4 a = sp[0], b = sp[1], c = sp[2], d = sp[3];
                    const float ss = ((a[0] + a[1]) + (a[2] + a[3])) + ((b[0] + b[1]) + (b[2] + b[3])) + ((c[0] + c[1]) + (c[2] + c[3])) + ((d[0] + d[1]) + (d[2] + d[3]));
                    rs = 1.0f / sqrtf(ss * (1.0f / 1024.0f) + EPS); }
#pragma unroll
                for (int bj = 0; bj < 2; ++bj) { const int c = u.pn * 256 + bj * 128 + wc * 32 + 8 * fq;
                    if (sg == 0) scale8(acc[ai][bj][m][0], acc[ai][bj][m][1], rowp + lg_col(0, c), rowp + lg_col(1, c), rs);
                    else         scale8(acc[ai][bj][m][0], acc[ai][bj][m][1], rowp + lg_col(2, c), rowp + lg_col(0, c), 1.0f); }
                asm volatile("" ::: "memory"); }
    }
    __device__ __forceinline__ void operator()(const f32x4 (&acc)[2][2][4][2], const pg8::Unit& u, int wr, int wc, int fr, int fq) const {
        int row0 = u.pm * 256 + wr * 64 + fr; asm volatile("" : "+v"(row0));
#pragma unroll
        for (int ai = 0; ai < 2; ++ai)
#pragma unroll
            for (int m = 0; m < 4; ++m) { const int row = row0 + ai * 128 + m * 16; const bf16_t* rowp = PA + (size_t)row * NA;
#pragma unroll
                for (int bj = 0; bj < 2; ++bj) { const int c = u.pn * 256 + bj * 128 + wc * 32 + 8 * fq;
                    f32x4 v0 = acc[ai][bj][m][0], v1 = acc[ai][bj][m][1];
                    scale8(v0, v1, nullptr, rowp + lg_col(2, c), 1.0f);
                    u32x4 w; w.x = cvt_pk_bf16(v0[0], v0[1]); w.y = cvt_pk_bf16(v0[2], v0[3]); w.z = cvt_pk_bf16(v1[0], v1[1]); w.w = cvt_pk_bf16(v1[2], v1[3]);
                    *(u32x4*)(MG + (size_t)row * 1024 + c) = w; }
                asm volatile("" ::: "memory"); }
    }
};
struct EpiOut {
    static constexpr bool PERM = false;
    const float* xin; float* xout; const float* rgate;
    __device__ __forceinline__ void mid(f32x4 (&)[2][2][4][2], const pg8::Unit&, int, int, int, int, int) const {}
    __device__ __forceinline__ void operator()(const f32x4 (&acc)[2][2][4][2], const pg8::Unit& u, int wr, int wc, int fr, int fq) const {
        int row0 = u.pm * 256 + wr * 64 + fr, col0 = u.pn * 256 + wc * 32 + 4 * fq; asm volatile("" : "+v"(row0), "+v"(col0));
        const float* rg = rgate + (size_t)(u.pm / 8) * 3072 + col0;
        f32x4 gv[2][2];
#pragma unroll
        for (int bj = 0; bj < 2; ++bj)
#pragma unroll
            for (int n = 0; n < 2; ++n) gv[bj][n] = *(const f32x4*)(rg + bj * 128 + n * 16);
#pragma unroll
        for (int ai = 0; ai < 2; ++ai)
#pragma unroll
            for (int m = 0; m < 4; ++m) { const size_t off = (size_t)(row0 + ai * 128 + m * 16) * D + col0;
#pragma unroll
                for (int bj = 0; bj < 2; ++bj)
#pragma unroll
                    for (int n = 0; n < 2; ++n) { const f32x4 xv = *(const f32x4*)(xin + off + bj * 128 + n * 16);
                        *(f32x4*)(xout + off + bj * 128 + n * 16) = xv + gv[bj][n] * acc[ai][bj][m][n]; }
                asm volatile("" ::: "memory"); }
    }
};

struct KArgs { const void* in[19]; float* out; unsigned char* ws; int ph_lo, ph_hi; };
constexpr int ARGS_OFF = RING_BYTES + 512;
enum { I_X = 0, I_C, I_POS, I_NORM_G, I_W_ADA, I_B_ADA, I_W_IN, I_CONV_W, I_CONV_B, I_DT_BIAS, I_A_LOG, I_SSM_D, I_SSM_NORM_G, I_SC_CONV_W, I_W_BR_RET, I_W_BR_SSM, I_W_BR_SC, I_W_OUT, I_FINAL_G };
struct Args { LAS unsigned char* lds; float* out; unsigned char* ws;
    __device__ __forceinline__ const float* f(int i) const { const LAS unsigned* p = (const LAS unsigned*)(lds + ARGS_OFF) + 2 * i;
        const unsigned lo = __builtin_amdgcn_readfirstlane(p[0]), hi = __builtin_amdgcn_readfirstlane(p[1]); return (const float*)(((unsigned long long)hi << 32) | lo); }
};
#define ARGF(name, idx) const float* const name = a.f(idx)

__device__ __forceinline__ int win_srccol(int n) {
    if (n < 4608) return n;
    if (n < N1A) { const int p = (n - 4608) & 255, tt = (n - 4608) >> 8; const int bj = p >> 7, wc = (p >> 5) & 3, fq = (p >> 3) & 3, nn = (p >> 2) & 1, e = p & 3;
        const int q = 2 * bj + nn, ch = 64 * tt + 16 * wc + 4 * fq + e; return C_CB + 512 * q + ch; }
    return C_MG + (n - N1A);
}
template <bool MAP>
__device__ __forceinline__ void transpose_item(const float* W, int ldsrc, int k0, bf16_t* WT, int ldd, int dk0, int n0, const float* scale, LAS float* scr, int lane) {
    const int nsrc = MAP ? win_srccol(n0 + (lane & 31)) : n0 + (lane & 31);
#pragma unroll 8
    for (int i = 0; i < 32; ++i) { const int kk = 2 * i + (lane >> 5); float v = W[(size_t)(k0 + kk) * ldsrc + nsrc]; if (scale) v *= scale[k0 + kk]; scr[kk * 33 + (lane & 31)] = v; }
    LDS_WAIT(); asm volatile("" ::: "memory");
    const int c = lane & 7;
#pragma unroll
    for (int j = 0; j < 4; ++j) { const int n = (lane >> 3) + 8 * j; const LAS float* s = scr + (8 * c) * 33 + n;
        u32x4 o; o.x = pk2(s[0 * 33], s[1 * 33]); o.y = pk2(s[2 * 33], s[3 * 33]); o.z = pk2(s[4 * 33], s[5 * 33]); o.w = pk2(s[6 * 33], s[7 * 33]);
        *(u32x4*)(WT + (size_t)(n0 + n) * ldd + dk0 + 8 * c) = o; }
    LDS_WAIT(); asm volatile("" ::: "memory");
}
__device__ __forceinline__ void convert_weights(const Args& a, int l, LAS unsigned char* lds, int gw, int NGW, int wave, int lane) {
    LAS float* scr = (LAS float*)(lds + wave * 16384);
    bf16_t* WinT = (bf16_t*)(a.ws + WS_WIN); bf16_t* WbrT = (bf16_t*)(a.ws + WS_WBR); bf16_t* WoutT = (bf16_t*)(a.ws + WS_WOUT);
    const float* w_in = a.f(I_W_IN) + (size_t)l * 1024 * IN_W;
    constexpr int I_IN = (NW1 / 32) * 16, I_BR = 32 * 32, I_OUT = 32 * 16;
    for (int it = gw; it < I_IN + I_BR + I_OUT; it += NGW) {
        int r = it;
        if (r < I_IN) { const int nb = r / 16, kb = r % 16; transpose_item<true>(w_in, IN_W, 64 * kb, WinT, 1024, 64 * kb, 32 * nb, nullptr, scr, lane); continue; }
        r -= I_IN;
        if (r < I_BR) { const int nb = r / 32, kb = r % 32;
            if (kb < 16) transpose_item<false>(a.f(I_W_BR_SSM) + (size_t)l * 1024 * 1024, 1024, 64 * kb, WbrT, 2048, 64 * kb, 32 * nb, a.f(I_SSM_NORM_G) + l * 1024, scr, lane);
            else if (kb < 24) transpose_item<false>(a.f(I_W_BR_RET) + (size_t)l * 512 * 1024, 1024, 64 * (kb - 16), WbrT, 2048, 64 * kb, 32 * nb, nullptr, scr, lane);
            else transpose_item<false>(a.f(I_W_BR_SC) + (size_t)l * 512 * 1024, 1024, 64 * (kb - 24), WbrT, 2048, 64 * kb, 32 * nb, nullptr, scr, lane);
            continue; }
        r -= I_BR;
        { const int nb = r / 16, kb = r % 16; transpose_item<false>(a.f(I_W_OUT) + (size_t)l * 1024 * 1024, 1024, 64 * kb, WoutT, 1024, 64 * kb, 32 * nb, nullptr, scr, lane); }
    }
}

__device__ __attribute__((noinline)) void phase_p0(const Args a, LAS unsigned char* lds, int bid, int nblk, int tid, int wave, int lane) {
    float* ada = (float*)(a.ws + WS_ADA);
    LAS float* scs = (LAS float*)lds;
    LAS float* red = (LAS float*)(lds + 32768);
    for (int i = tid; i < 8 * 1024; i += 512) scs[i] = silu_f(a.f(I_C)[i]);
    __syncthreads();
    for (int item = bid; item < 256; item += nblk) {
        const int l = item >> 7, j0 = 24 * (item & 127);
        if (tid < 504) { const int jl = tid % 24, kg = tid / 24; float acc[8];
#pragma unroll
            for (int b = 0; b < 8; ++b) acc[b] = 0.f;
            const float* w = a.f(I_W_ADA) + (size_t)l * 1024 * 3072 + j0 + jl;
            for (int k = kg; k < 1024; k += 21) { const float wv = w[(size_t)k * 3072];
#pragma unroll
                for (int b = 0; b < 8; ++b) acc[b] += scs[b * 1024 + k] * wv; }
#pragma unroll
            for (int b = 0; b < 8; ++b) red[(kg * 24 + jl) * 8 + b] = acc[b]; }
        __syncthreads();
        if (tid < 192) { const int jl = tid >> 3, b = tid & 7; float s = 0.f;
            for (int kg = 0; kg < 21; ++kg) s += red[(kg * 24 + jl) * 8 + b];
            ada[((size_t)l * 8 + b) * 3072 + j0 + jl] = s + a.f(I_B_ADA)[l * 3072 + j0 + jl]; }
        __syncthreads();
    }
    float* cs = (float*)(a.ws + WS_CS);
    for (int idx = bid * 512 + tid; idx < T * 64; idx += nblk * 512) { const int t = idx >> 6, i = idx & 63;
        const float inv_freq = powf(10000.0f, -(float)(2 * i) / 128.0f); const float ang = (float)((const int*)a.f(I_POS))[t] * inv_freq;
        cs[2 * (size_t)idx] = cosf(ang); cs[2 * (size_t)idx + 1] = sinf(ang); }
    __syncthreads();
    convert_weights(a, 0, lds, bid * 8 + wave, nblk * 8, wave, lane);
}

__device__ __attribute__((noinline)) void phase_hprep(const Args a, int l, const float* xcur, LAS unsigned char* lds, int bid, int nblk, int tid, int wave, int lane) {
    if (l > 0) { convert_weights(a, l, lds, bid * 8 + wave, nblk * 8, wave, lane); __syncthreads(); }
    LAS float* wt = (LAS float*)lds;
    const float* w_in = a.f(I_W_IN) + (size_t)l * 1024 * IN_W;
    for (int i = tid; i < 16 * 1024; i += 512) { const int c = i >> 4, j = i & 15; wt[j * 1024 + c] = w_in[(size_t)c * IN_W + C_DT + j]; }
    __syncthreads();
    const float* ada = (const float*)(a.ws + WS_ADA) + (size_t)l * 8 * 3072;
    bf16_t* H = (bf16_t*)(a.ws + WS_H); float* DT = (float*)(a.ws + WS_DT);
    const float* ng = a.f(I_NORM_G) + l * 1024;
    const int gw = bid * 8 + wave, NGW = nblk * 8;
    for (int tok = gw; tok < T; tok += NGW) {
        const int b = tok >> 11;
        const f32x4* xr = (const f32x4*)(xcur + (size_t)tok * D) + lane;
        f32x4 v[4]; float s = 0.f;
#pragma unroll
        for (int j = 0; j < 4; ++j) { v[j] = xr[64 * j]; s += (v[j][0] * v[j][0] + v[j][1] * v[j][1]) + (v[j][2] * v[j][2] + v[j][3] * v[j][3]); }
        const float rstd = 1.0f / sqrtf(wave_sum(s) * (1.0f / D) + EPS);
        const float* shift = ada + (size_t)b * 3072; const float* scale = shift + 1024;
#pragma unroll
        for (int j = 0; j < 4; ++j) { const int c = 4 * lane + 256 * j;
            const f32x4 g = *(const f32x4*)(ng + c), sc = *(const f32x4*)(scale + c), sh = *(const f32x4*)(shift + c);
            v[j] = (v[j] * rstd) * g * (sc + 1.0f) + sh; }
        unsigned long long* o8 = (unsigned long long*)(H + (size_t)tok * D) + lane;
#pragma unroll
        for (int j = 0; j < 4; ++j) o8[64 * j] = (unsigned long long)pk2(v[j][0], v[j][1]) | ((unsigned long long)pk2(v[j][2], v[j][3]) << 32);
        float mine = 0.f;
#pragma unroll 2
        for (int jj = 0; jj < 16; ++jj) { float p = 0.f;
#pragma unroll
            for (int j = 0; j < 4; ++j) { const f32x4 w = *(const LAS f32x4*)(wt + jj * 1024 + 4 * lane + 256 * j); p += (v[j][0] * w[0] + v[j][1] * w[1]) + (v[j][2] * w[2] + v[j][3] * w[3]); }
            p = wave_sum(p); mine = (lane == jj) ? p : mine; }
        if (lane < 16) { const float xv = mine + a.f(I_DT_BIAS)[l * 16 + lane]; DT[(size_t)tok * 16 + lane] = xv > 20.f ? xv : log1pf(__expf(xv)); }
    }
}

__device__ __forceinline__ void ret_item(const Args& a, int b, int h, LAS unsigned char* lds, int tid, int wave, int lane) {
    bf16_t* PA = (bf16_t*)(a.ws + WS_PA); const float* CS = (const float*)(a.ws + WS_CS);
    LAS float* qs = (LAS float*)lds; LAS float* ks = qs + 32 * 128; LAS float* vs = ks + 32 * 128; LAS float* red = vs + 32 * 128;
    const float gamma = 1.0f - exp2f(-5.0f - (float)h);
    const int e = tid & 127, dg = tid >> 7;
    float S[32];
#pragma unroll
    for (int i = 0; i < 32; ++i) S[i] = 0.f;
    for (int t0 = 0; t0 < SEQ; t0 += 32) {
        __syncthreads();
#pragma unroll
        for (int r = 0; r < 4; ++r) { const int idx = tid + 512 * r, tok = idx >> 6, i = idx & 63; const size_t row = (size_t)b * SEQ + t0 + tok;
            const float cc = CS[(row * 64 + i) * 2], sn = CS[(row * 64 + i) * 2 + 1];
            const bf16_t* pr = PA + row * NA;
            const float q1 = bf2f(pr[PA_Q + 128 * h + i]), q2 = bf2f(pr[PA_Q + 128 * h + 64 + i]);
            const float k1 = bf2f(pr[PA_K + 128 * h + i]), k2 = bf2f(pr[PA_K + 128 * h + 64 + i]);
            const float qsc = 0.08838834764831845f;
            qs[tok * 128 + i] = (q1 * cc - q2 * sn) * qsc; qs[tok * 128 + 64 + i] = (q1 * sn + q2 * cc) * qsc;
            ks[tok * 128 + i] = k1 * cc - k2 * sn; ks[tok * 128 + 64 + i] = k1 * sn + k2 * cc; }
#pragma unroll
        for (int r = 0; r < 8; ++r) { const int idx = tid + 512 * r, tok = idx >> 7, ee = idx & 127; const size_t row = (size_t)b * SEQ + t0 + tok;
            vs[tok * 128 + ee] = bf2f(PA[row * NA + PA_V + 128 * h + ee]); }
        __syncthreads();
        for (int tok = 0; tok < 32; ++tok) {
            const float v = vs[tok * 128 + e]; float part = 0.f;
#pragma unroll
            for (int i = 0; i < 32; ++i) { const int d = 32 * dg + i; S[i] = gamma * S[i] + ks[tok * 128 + d] * v; part += qs[tok * 128 + d] * S[i]; }
            red[(dg * 32 + tok) * 128 + e] = part;
        }
        __syncthreads();
#pragma unroll
        for (int tt = 0; tt < 4; ++tt) { const int tok = 4 * wave + tt; const size_t row = (size_t)b * SEQ + t0 + tok;
            float o0 = 0.f, o1 = 0.f;
#pragma unroll
            for (int g = 0; g < 4; ++g) { o0 += red[(g * 32 + tok) * 128 + lane]; o1 += red[(g * 32 + tok) * 128 + 64 + lane]; }
            const float mean = wave_sum(o0 + o1) * (1.0f / 128.0f); const float d0 = o0 - mean, d1 = o1 - mean;
            const float var = wave_sum(d0 * d0 + d1 * d1) * (1.0f / 128.0f); const float rstd = 1.0f / sqrtf(var + EPS);
            bf16_t* gp = PA + row * NA + PA_G + 128 * h;
            const float g0 = bf2f(gp[lane]), g1 = bf2f(gp[64 + lane]);
            gp[lane] = (bf16_t)f2bf(d0 * rstd * silu_f(g0)); gp[64 + lane] = (bf16_t)f2bf(d1 * rstd * silu_f(g1)); }
    }
}
__device__ __forceinline__ void ssd_item(const Args& a, int l, int b, int head, LAS unsigned char* lds, int tid, int wave, int lane) {
    bf16_t* PA = (bf16_t*)(a.ws + WS_PA); const float* DT = (const float*)(a.ws + WS_DT); float* SSQ = (float*)(a.ws + WS_SSQ);
    LAS float* xs = (LAS float*)lds; LAS float* Bs = xs + 32 * 64; LAS float* Cs = Bs + 32 * 128; LAS float* dts = Cs + 32 * 128; LAS float* red = dts + 32;
    const int g = head >> 3;
    const float A = -__expf(a.f(I_A_LOG)[l * 16 + head]), Dh = a.f(I_SSM_D)[l * 16 + head];
    const float* cw = a.f(I_CONV_W) + (size_t)l * 4 * 1536; const float* cb = a.f(I_CONV_B) + (size_t)l * 1536;
    const int p = tid & 63, ng = tid >> 6;
    float hs[16];
#pragma unroll
    for (int i = 0; i < 16; ++i) hs[i] = 0.f;
    for (int t0 = 0; t0 < SEQ; t0 += 32) {
        __syncthreads();
        for (int idx = tid; idx < 32 * 320; idx += 512) { const int tok = idx / 320, cc = idx % 320;
            int ch; LAS float* dst;
            if (cc < 64) { ch = 64 * head + cc; dst = xs + tok * 64 + cc; } else if (cc < 192) { ch = 1024 + 128 * g + (cc - 64); dst = Bs + tok * 128 + (cc - 64); } else { ch = 1280 + 128 * g + (cc - 192); dst = Cs + tok * 128 + (cc - 192); }
            const int tl = t0 + tok; float s = cb[ch];
#pragma unroll
            for (int k = 0; k < 4; ++k) { const int ts = tl - 3 + k; if (ts >= 0) s += cw[k * 1536 + ch] * bf2f(PA[((size_t)b * SEQ + ts) * NA + PA_XBC + ch]); }
            *dst = silu_f(s); }
        if (tid < 32) dts[tid] = DT[((size_t)b * SEQ + t0 + tid) * 16 + head];
        __syncthreads();
        for (int tok = 0; tok < 32; ++tok) {
            const float dt = dts[tok], dA = __expf(dt * A), xv = xs[tok * 64 + p] * dt; float part = 0.f;
#pragma unroll
            for (int i = 0; i < 16; ++i) { const int n = 16 * ng + i; hs[i] = dA * hs[i] + xv * Bs[tok * 128 + n]; part += hs[i] * Cs[tok * 128 + n]; }
            red[(ng * 32 + tok) * 64 + p] = part;
        }
        __syncthreads();
#pragma unroll
        for (int tt = 0; tt < 4; ++tt) { const int tok = 4 * wave + tt; const size_t row = (size_t)b * SEQ + t0 + tok;
            float y = Dh * xs[tok * 64 + lane];
#pragma unroll
            for (int q = 0; q < 8; ++q) y += red[(q * 32 + tok) * 64 + lane];
            bf16_t* zp = PA + row * NA + PA_Z + 64 * head;
            y *= silu_f(bf2f(zp[lane]));
            const float ss = wave_sum(y * y);
            zp[lane] = (bf16_t)f2bf(y);
            if (lane == 0) SSQ[row * 16 + head] = ss; }
    }
}
__device__ __forceinline__ void sc_items(const Args& a, int l, int vb, int nvb, int tid) {
    bf16_t* PA = (bf16_t*)(a.ws + WS_PA); const float* cw = a.f(I_SC_CONV_W) + (size_t)l * 3 * 512;
    for (int idx = vb * 512 + tid; idx < T * 64; idx += nvb * 512) { const int row = idx >> 6, c0 = (idx & 63) * 8; const int tl = row & (SEQ - 1);
        bf16_t* rp = PA + (size_t)row * NA;
        const u32x4 u2 = *(const u32x4*)(rp + PA_U + c0);
        u32x4 u1 = (u32x4){0u, 0u, 0u, 0u}, u0 = u1;
        if (tl >= 1) u1 = *(const u32x4*)(rp - NA + PA_U + c0);
        if (tl >= 2) u0 = *(const u32x4*)(rp - 2 * NA + PA_U + c0);
        const u32x4 wv = *(const u32x4*)(rp + PA_W + c0);
        float o[8];
#pragma unroll
        for (int j = 0; j < 4; ++j) { const int ca = c0 + 2 * j, cbb = ca + 1;
            o[2 * j] = bflo(wv[j]) * (cw[ca] * bflo(u0[j]) + cw[512 + ca] * bflo(u1[j]) + cw[1024 + ca] * bflo(u2[j]));
            o[2 * j + 1] = bfhi(wv[j]) * (cw[cbb] * bfhi(u0[j]) + cw[512 + cbb] * bfhi(u1[j]) + cw[1024 + cbb] * bfhi(u2[j])); }
        u32x4 r; r.x = pk2(o[0], o[1]); r.y = pk2(o[2], o[3]); r.z = pk2(o[4], o[5]); r.w = pk2(o[6], o[7]);
        *(u32x4*)(rp + PA_W + c0) = r; }
}
__device__ __attribute__((noinline)) void phase_mixers_v1(const Args a, int l, LAS unsigned char* lds, int bid, int nblk, int tid, int wave, int lane) {
    if (bid < 32) ret_item(a, bid >> 2, bid & 3, lds, tid, wave, lane);
    else if (bid < 160) ssd_item(a, l, (bid - 32) >> 4, (bid - 32) & 15, lds, tid, wave, lane);
    else sc_items(a, l, bid - 160, nblk - 160, tid);
}

__device__ __attribute__((noinline)) void phase_final(const Args a, int bid, int nblk, int wave, int lane) {
    const int gw = bid * 8 + wave, NGW = nblk * 8;
    for (int tok = gw; tok < T; tok += NGW) {
        f32x4* xr = (f32x4*)(a.out + (size_t)tok * D) + lane;
        f32x4 v[4]; float s = 0.f;
#pragma unroll
        for (int j = 0; j < 4; ++j) { v[j] = xr[64 * j]; s += (v[j][0] * v[j][0] + v[j][1] * v[j][1]) + (v[j][2] * v[j][2] + v[j][3] * v[j][3]); }
        const float rstd = 1.0f / sqrtf(wave_sum(s) * (1.0f / D) + EPS);
#pragma unroll
        for (int j = 0; j < 4; ++j) { const f32x4 g = *(const f32x4*)(a.f(I_FINAL_G) + 4 * lane + 256 * j); xr[64 * j] = (v[j] * rstd) * g; }
    }
}

constexpr int NPHASE = 14;
__global__ void __launch_bounds__(512, 2) mk_fwd(KArgs ka) {
    extern __shared__ __attribute__((aligned(16))) unsigned char lds_raw[];
    LAS unsigned char* lds = (LAS unsigned char*)lds_raw;
    const int tid0 = threadIdx.x, wave = __builtin_amdgcn_readfirstlane(tid0 >> 6);
    const int bid = blockIdx.x, nblk = gridDim.x;
    volatile LAS unsigned* MISC = (volatile LAS unsigned*)(lds + MISC_OFF);
    for (int u = tid0; u < (LDS_BYTES - RING_BYTES) / 4; u += 512) ((LAS unsigned*)(lds + RING_BYTES))[u] = 0u;
    __syncthreads();
    if (tid0 == 0) {
#pragma unroll
        for (int i = 0; i < 19; ++i) { const unsigned long long v = (unsigned long long)ka.in[i]; ((LAS unsigned*)(lds + ARGS_OFF))[2 * i] = (unsigned)v; ((LAS unsigned*)(lds + ARGS_OFF))[2 * i + 1] = (unsigned)(v >> 32); } }
    __syncthreads();
    unsigned* ctl = (unsigned*)(ka.ws + WS_CTL);
    XcdBarrier bar; bar.bar = ctl + CW_BAR; bar.x = 0; bar.st = nullptr;
    if (!MK_SPLIT) bar = xcd_barrier_post(ctl + CW_BAR, MISC + 8);
    const int lo = ka.ph_lo, hi = ka.ph_hi;
#pragma unroll 1
    for (int ph = lo; ph < hi; ++ph) {
        int tid = tid0; asm volatile("" : "+v"(tid)); const int lane = tid & 63;
        Args a; a.lds = lds; a.out = ka.out; a.ws = ka.ws; asm volatile("" : "+s"(a.ws), "+s"(a.out));
        bf16_t* PA = (bf16_t*)(a.ws + WS_PA); bf16_t* H = (bf16_t*)(a.ws + WS_H);
        const bf16_t* WinT = (const bf16_t*)(a.ws + WS_WIN); const bf16_t* WbrT = (const bf16_t*)(a.ws + WS_WBR); const bf16_t* WoutT = (const bf16_t*)(a.ws + WS_WOUT);
        const int l = ph >= 7 ? 1 : 0, k = ph - 1 - 6 * l;
        const float* xcur = l == 0 ? a.f(I_X) : a.out;
        if (ph == 0) { if (!(MK_OFF & 1)) phase_p0(a, lds, bid, nblk, tid, wave, lane); }
        else if (ph == 13) { if (!(MK_OFF & 128)) phase_final(a, bid, nblk, wave, lane); }
        else if (k == 0) { if (!(MK_OFF & 2)) phase_hprep(a, l, xcur, lds, bid, nblk, tid, wave, lane); }
        else if (k == 1) { if (!(MK_OFF & 4)) { pg8::Gemm g{H, 1024, WinT, T, N1A, 1024}; pg8::StaticOrder S; S.init(T, N1A, nblk, bid); EpiIn1 E{PA}; pg8::gemm_phase(lds, g, S, E, pg8::AMapLinear{}); } }
        else if (k == 2) { if (!(MK_OFF & 8)) phase_mixers_v1(a, l, lds, bid, nblk, tid, wave, lane); }
        else if (k == 3) { if (!(MK_OFF & 16)) { pg8::Gemm g{H, 1024, WinT + (size_t)N1A * 1024, T, N1B, 1024}; pg8::StaticOrder S; S.init(T, N1B, nblk, bid); EpiIn2 E{PA}; pg8::gemm_phase(lds, g, S, E, pg8::AMapLinear{}); } }
        else if (k == 4) { if (!(MK_OFF & 32)) { pg8::Gemm g{PA, NA, WbrT, T, 1024, 2048}; pg8::StaticOrder S; S.init(T, 1024, nblk, bid); EpiMerge E{PA, (const float*)(a.ws + WS_SSQ), H}; pg8::gemm_phase(lds, g, S, E, pg8::AMapBranch{}); } }
        else { if (!(MK_OFF & 64)) { pg8::Gemm g{H, 1024, WoutT, T, 1024, 1024}; pg8::StaticOrder S; S.init(T, 1024, nblk, bid);
            EpiOut E{xcur, a.out, (const float*)(a.ws + WS_ADA) + (size_t)l * 8 * 3072 + 2048}; pg8::gemm_phase(lds, g, S, E, pg8::AMapLinear{}); } }
        if (!MK_SPLIT && ph + 1 < hi) xcd_barrier(bar);
    }
}

extern "C" void kernel_launch(void* const* d_in, const int* in_sizes, int n_in, void* d_out, int out_size, void* d_ws, size_t ws_size, hipStream_t stream) {
    static int grid = 0;
    if (grid == 0) {
        if (n_in != 19 || in_sizes[0] != T * D || out_size != T * D || ws_size < WS_END) { fprintf(stderr, "kernel_launch: unexpected shapes (n_in %d, in0 %d, out %d, ws %zu, need %zu)\n", n_in, n_in > 0 ? in_sizes[0] : -1, out_size, ws_size, (size_t)WS_END); grid = -1; return; }
        int dev = 0, cus = 0, per_cu = 0;
        if (hipGetDevice(&dev) != hipSuccess || hipDeviceGetAttribute(&cus, hipDeviceAttributeMultiprocessorCount, dev) != hipSuccess) { grid = -1; return; }
        if (hipFuncSetAttribute((const void*)mk_fwd, hipFuncAttributeMaxDynamicSharedMemorySize, LDS_BYTES) != hipSuccess) { fprintf(stderr, "kernel_launch: hipFuncSetAttribute failed\n"); grid = -1; return; }
        if (hipOccupancyMaxActiveBlocksPerMultiprocessor(&per_cu, (const void*)mk_fwd, 512, LDS_BYTES) != hipSuccess || per_cu < 1) { fprintf(stderr, "kernel_launch: occupancy query says %d blocks per CU\n", per_cu); }
        (void)hipGetLastError();
        grid = cus;
        if (grid != 256) fprintf(stderr, "kernel_launch: %d CUs (built for 256)\n", grid);
    }
    if (grid < 0) return;
    (void)hipMemsetAsync((char*)d_ws + WS_CTL, 0, CTL_BYTES, stream);
    KArgs a{};
    for (int i = 0; i < 19; ++i) a.in[i] = d_in[i];
    a.out = (float*)d_out; a.ws = (unsigned char*)d_ws;
#if MK_SPLIT
    for (int ph = 0; ph < NPHASE && ph < MK_PH_HI; ++ph) { a.ph_lo = ph; a.ph_hi = ph + 1; hipLaunchKernelGGL(mk_fwd, dim3(grid), dim3(512), LDS_BYTES, stream, a); }
#else
    a.ph_lo = 0; a.ph_hi = NPHASE;
    hipLaunchKernelGGL(mk_fwd, dim3(grid), dim3(512), LDS_BYTES, stream, a);
#endif
}
```

```cpp
#include <hip/hip_runtime.h>
#include <cstdio>
#include <cstdint>

#ifndef MK_SPLIT
#define MK_SPLIT 0
#endif
#ifndef MK_OFF
#define MK_OFF 0
#endif
#ifndef MK_PH_HI
#define MK_PH_HI 1000
#endif

#define LAS __attribute__((address_space(3)))
#define GAS __attribute__((address_space(1)))
typedef unsigned short bf16_t;
typedef short bf16x8 __attribute__((ext_vector_type(8)));
typedef float f32x4 __attribute__((ext_vector_type(4)));
typedef float f32x2 __attribute__((ext_vector_type(2)));
typedef unsigned u32x4 __attribute__((ext_vector_type(4)));
typedef unsigned u32x2 __attribute__((ext_vector_type(2)));

constexpr int BATCH = 8, SEQ = 2048, D = 1024, T = BATCH * SEQ, DEPTH = 2;
constexpr int IN_W = 9744;
constexpr int C_RQ = 0, C_RK = 512, C_RV = 1024, C_RG = 1536, C_SZ = 2048, C_XBC = 3072, C_DT = 4608, C_CB = 4624, C_CC = 5136, C_CH = 5648, C_CG = 6160, C_MG = 6672;
constexpr int NA = 5632;
constexpr int PA_Q = 0, PA_K = 512, PA_V = 1024, PA_G = 1536, PA_Z = 2048, PA_XBC = 3072, PA_U = 4608, PA_W = 5120;
constexpr int N1A = 26 * 256, N1B = 12 * 256, NW1 = N1A + N1B;
constexpr float EPS = 1e-6f;

constexpr size_t WS_CTL = 0, CTL_BYTES = 1u << 20;
constexpr size_t WS_ADA = WS_CTL + CTL_BYTES;
constexpr size_t WS_CS = WS_ADA + (size_t)2 * 8 * 3072 * 4;
constexpr size_t WS_DT = WS_CS + (size_t)T * 64 * 2 * 4;
constexpr size_t WS_SSQ = WS_DT + (size_t)T * 16 * 4;
constexpr size_t WS_WIN = WS_SSQ + (size_t)T * 16 * 4;
constexpr size_t WS_WBR = WS_WIN + (size_t)NW1 * 1024 * 2;
constexpr size_t WS_WOUT = WS_WBR + (size_t)1024 * 2048 * 2;
constexpr size_t WS_H = WS_WOUT + (size_t)1024 * 1024 * 2;
constexpr size_t WS_PA = WS_H + (size_t)T * 1024 * 2;
constexpr size_t WS_RS = WS_PA + (size_t)T * NA * 2;
constexpr size_t WS_SS = WS_RS + (size_t)512 * 128 * 128 * 2;
constexpr size_t WS_CD = WS_SS + (size_t)2048 * 64 * 128 * 2;
constexpr size_t WS_END = WS_CD + (size_t)2048 * 4;
static_assert(WS_END <= 319291392ull, "workspace");

constexpr int CW_BAR = 4096;

constexpr int RING_BYTES = 131072;
constexpr int MISC_OFF = RING_BYTES + 320;
constexpr int LDS_BYTES = 147456;

#define LDS_WAIT() asm volatile("s_waitcnt lgkmcnt(0)" ::: "memory")
#define VM_WAIT() asm volatile("s_waitcnt vmcnt(0)" ::: "memory")
__device__ __forceinline__ unsigned f2bf(float f) { unsigned u = __builtin_bit_cast(unsigned, f); return (u + 0x7fffu + ((u >> 16) & 1u)) >> 16; }
__device__ __forceinline__ unsigned pk2(float lo, float hi) { return f2bf(lo) | (f2bf(hi) << 16); }
__device__ __forceinline__ float bf2f(unsigned short b) { return __builtin_bit_cast(float, ((unsigned)b) << 16); }
__device__ __forceinline__ float bflo(unsigned w) { return __builtin_bit_cast(float, w << 16); }
__device__ __forceinline__ float bfhi(unsigned w) { return __builtin_bit_cast(float, w & 0xffff0000u); }
#define SWZ_XOR(v, m) __builtin_bit_cast(float, __builtin_amdgcn_ds_swizzle(__builtin_bit_cast(int, (v)), (((m) << 10) | 0x1f)))
__device__ __forceinline__ float wave_sum(float v) {
    v += SWZ_XOR(v, 1); v += SWZ_XOR(v, 2); v += SWZ_XOR(v, 4); v += SWZ_XOR(v, 8); v += SWZ_XOR(v, 16);
    return __builtin_bit_cast(float, __builtin_amdgcn_readlane(__builtin_bit_cast(int, v), 0)) + __builtin_bit_cast(float, __builtin_amdgcn_readlane(__builtin_bit_cast(int, v), 32));
}
__device__ __forceinline__ float silu_f(float x) { return x / (1.0f + __expf(-x)); }

#define XB_TMO      128
#define XB_XCNT(j)  (256  + 64 * (j))
#define XB_XSUB(j)  (1280 + 64 * (j))
#define XB_XGEN(j)  (2304 + 64 * (j))
#define XB_TOP      3328
#define XB_TOPGEN   3392
#define XCD_BAR_WORDS 3456
#define XB_SPIN_CAP (1u << 18)
__device__ __forceinline__ unsigned xb_ld(unsigned* p)              { return __hip_atomic_load(p, __ATOMIC_RELAXED, __HIP_MEMORY_SCOPE_AGENT); }
__device__ __forceinline__ unsigned xb_add(unsigned* p, unsigned v) { return __hip_atomic_fetch_add(p, v, __ATOMIC_RELAXED, __HIP_MEMORY_SCOPE_AGENT); }
__device__ __forceinline__ unsigned xb_xcc_id() { return (unsigned)__builtin_amdgcn_s_getreg((3 << 11) | 20) & 0xFu; }
#define XB_SPIN(cond, bar) do { unsigned _sp = 0; while (cond) { __builtin_amdgcn_s_sleep(1); \
    if ((++_sp & 255u) == 0u) { if (xb_ld(&(bar)[XB_TMO])) break; if (_sp > XB_SPIN_CAP) { atomicAdd(&(bar)[XB_TMO], 1u); break; } } } } while (0)
struct XcdBarrier { unsigned* bar; unsigned x; volatile LAS unsigned* st; };
__device__ __forceinline__ XcdBarrier xcd_barrier_post(unsigned* bar, volatile LAS unsigned* st) {
    XcdBarrier b; b.bar = bar; b.x = xb_xcc_id(); b.st = st;
    if (threadIdx.x == 0) (void)xb_add(&bar[XB_XCNT(b.x)], 1u);
    return b;
}
__device__ __forceinline__ void xcd_barrier_complete(unsigned* bar, unsigned x, unsigned& nloc, unsigned& nx) {
    const unsigned G = gridDim.x * gridDim.y * gridDim.z;
    unsigned sum, cnt, mine, sp = 0u;
    for (;;) {
        sum = 0u; cnt = 0u; mine = 0u;
#pragma unroll 1
        for (unsigned j = 0; j < 16; ++j) { const unsigned c = xb_ld(&bar[XB_XCNT(j)]); sum += c; cnt += (c > 0u) ? 1u : 0u; mine = (j == x) ? c : mine; }
        if (sum == G) break;
        __builtin_amdgcn_s_sleep(1);
        if ((++sp & 255u) == 0u) { if (xb_ld(&bar[XB_TMO])) break; if (sp > XB_SPIN_CAP) { atomicAdd(&bar[XB_TMO], 1u); break; } }
    }
    nloc = mine > 0u ? mine : 1u; nx = cnt > 0u ? cnt : 1u;
}
__device__ __forceinline__ void xcd_barrier(const XcdBarrier& b) {
    asm volatile("s_waitcnt vmcnt(0)" ::: "memory");
    __syncthreads();
    if (threadIdx.x == 0) {
        unsigned* bar = b.bar;
        __builtin_amdgcn_s_waitcnt(0);
        unsigned nloc = b.st[0], nx = b.st[1];
        if (nloc == 0u) { xcd_barrier_complete(bar, b.x, nloc, nx); b.st[0] = nloc; b.st[1] = nx; }
        const unsigned old = xb_add(&bar[XB_XSUB(b.x)], 1u);
        const unsigned gen = old / nloc;
        if (old + 1u == (gen + 1u) * nloc) {
            __builtin_amdgcn_fence(__ATOMIC_RELEASE, "agent");
            asm volatile("s_waitcnt vmcnt(0)" ::: "memory");
            const unsigned og = xb_add(&bar[XB_TOP], 1u);
            const unsigned tg = og / nx;
            if (og + 1u == (tg + 1u) * nx) xb_add(&bar[XB_TOPGEN], 1u);
            else XB_SPIN(xb_ld(&bar[XB_TOPGEN]) == tg, bar);
            __builtin_amdgcn_fence(__ATOMIC_ACQUIRE, "agent");
            xb_add(&bar[XB_XGEN(b.x)], 1u);
            asm volatile("s_waitcnt vmcnt(0)" ::: "memory");
        } else {
            XB_SPIN(xb_ld(&bar[XB_XGEN(b.x)]) == gen, bar);
            __builtin_amdgcn_fence(__ATOMIC_ACQUIRE, "agent");
            asm volatile("s_waitcnt vmcnt(0)" ::: "memory");
        }
    }
    __syncthreads();
}

namespace pg8 {
constexpr int BM = 256, BK = 64, HALF = 128, HTB = HALF * BK * 2, STAGE_BYTES = 8 * HTB, NXCD = 8, WGM = 8;
__host__ __device__ __forceinline__ int lds_byte(int r, int c) { const int st = (r >> 4) * 2 + (c >> 5), rr = r & 15, cc = c & 31, ob = rr * 64 + cc * 2; return st * 1024 + (ob ^ (((ob >> 9) & 1) << 5)); }
__host__ __device__ __forceinline__ void stage_rc(int b, int& R, int& C) { const int st = b / 1024, sb = b % 1024, swz = sb ^ (((sb >> 9) & 1) << 5); R = (st >> 1) * 16 + swz / 64; C = (st & 1) * 32 + (swz % 64) / 2; }
__host__ __device__ __forceinline__ int perm32(int rho) { const int n = rho >> 4, i = rho & 15; return 8 * (i >> 2) + 4 * n + (i & 3); }
struct Unit { int pm, pn; };
struct Gemm { const bf16_t* A; int lda; const bf16_t* Bt; int M, N, K; };
struct StaticOrder {
    int nM, nN, nwg, G, c;
    __device__ void init(int M, int N, int G_, int c_) { nM = M / BM; nN = N / BM; nwg = nM * nN; G = G_; c = c_; }
    __device__ bool next(int i, Unit& u) const {
        const long L = (long)i * G + c; if (L >= nwg) return false;
        int wgid = (int)L; { const int q = nwg / NXCD, r = nwg % NXCD, xcd = wgid % NXCD, off = wgid / NXCD; wgid = (xcd < r ? xcd * (q + 1) : r * (q + 1) + (xcd - r) * q) + off; }
        const int nig = WGM * nN, gid = wgid / nig, fm = gid * WGM, gsz = (nM - fm) < WGM ? (nM - fm) : WGM;
        u.pm = fm + ((wgid % nig) % gsz); u.pn = (wgid % nig) / gsz; return true;
    }
};
__device__ __forceinline__ unsigned cvt_pk_bf16(float lo, float hi) { unsigned r; asm volatile("v_cvt_pk_bf16_f32 %0, %1, %2" : "=v"(r) : "v"(lo), "v"(hi)); return r; }

struct AMapLinear { static constexpr int NSEG = 1; __device__ __forceinline__ int seg_end(int, int nt) const { return nt; } __device__ __forceinline__ size_t koff(int t) const { return (size_t)t * (BK * 2); } };
struct AMapBranch { static constexpr int NSEG = 3; __device__ __forceinline__ int seg_end(int sg, int) const { return sg == 0 ? 16 : (sg == 1 ? 24 : 32); } __device__ __forceinline__ size_t koff(int t) const { const int col = t < 16 ? PA_Z + 64 * t : (t < 24 ? PA_G + 64 * (t - 16) : PA_W + 64 * (t - 24)); return (size_t)col * 2; } };

template <class Epi, class AMap>
__device__ __forceinline__ void gemm_phase(LAS unsigned char* lds, const Gemm g, const StaticOrder& S, const Epi& E, const AMap AM) {
    int tid = threadIdx.x; asm volatile("" : "+v"(tid));
    const int wid = __builtin_amdgcn_readfirstlane(tid >> 6), lane = tid & 63, wr = wid >> 2, wc = wid & 3, fr = lane & 15, fq = lane >> 4;
    const int K = g.K, nt = K / BK;
    unsigned voffA[2], voffB[2];
#pragma unroll
    for (int i = 0; i < 2; ++i) { int R, C; stage_rc(tid * 16 + i * 8192, R, C); const int Rb = Epi::PERM ? ((R & ~31) + perm32(R & 31)) : R;
        voffA[i] = (unsigned)(R * g.lda + C) * 2u; voffB[i] = (unsigned)(Rb * K + C) * 2u; }
    const size_t kstep = (size_t)(BK * 2);
    const size_t hstepA = (size_t)HALF * g.lda * 2, hstepB = (size_t)HALF * K * 2;
    const size_t tstepA = 2 * hstepA, tstepB = 2 * hstepB;
    const unsigned ldsw = (unsigned)wid * 1024u;
    const int aoff = lds_byte(wr * 64 + fr, fq * 8), boff = lds_byte(wc * 32 + fr, fq * 8);
#define PG8_SA(b, h) (((b) * 2 + (h)) * HTB)
#define PG8_SB(b, h) ((4 + (b) * 2 + (h)) * HTB)
#define PG8_STAGE(bufoff, gbase, voff) do { _Pragma("unroll") for (int _i = 0; _i < 2; ++_i) \
        __builtin_amdgcn_global_load_lds((const unsigned*)((const char*)(gbase) + (voff)[_i]), (LAS unsigned*)(lds + (bufoff) + ldsw + _i * 8192), 16, 0, 0); } while (0)
#define PG8_LDA(dst, b, h) do { _Pragma("unroll") for (int m = 0; m < 4; ++m) _Pragma("unroll") for (int k = 0; k < 2; ++k) dst[m][k] = *(const LAS bf16x8*)(lds + PG8_SA(b, h) + aoff + m * 2048 + k * 1024); } while (0)
#define PG8_LDB(dst, b, h) do { _Pragma("unroll") for (int n = 0; n < 2; ++n) _Pragma("unroll") for (int k = 0; k < 2; ++k) dst[n][k] = *(const LAS bf16x8*)(lds + PG8_SB(b, h) + boff + n * 2048 + k * 1024); } while (0)
#define PG8_MMA(ai, bj, At, Bt) do { __builtin_amdgcn_s_setprio(1); _Pragma("unroll") for (int m = 0; m < 4; ++m) _Pragma("unroll") for (int n = 0; n < 2; ++n) _Pragma("unroll") for (int k = 0; k < 2; ++k) \
        acc[ai][bj][m][n] = __builtin_amdgcn_mfma_f32_16x16x32_bf16(Bt[n][k], At[m][k], acc[ai][bj][m][n], 0, 0, 0); __builtin_amdgcn_s_setprio(0); } while (0)
#define PG8_WAIT_V(n) asm volatile("s_waitcnt vmcnt(" #n ")" ::: "memory")
#define PG8_WAIT_L(n) asm volatile("s_waitcnt lgkmcnt(" #n ")" ::: "memory")
#define PG8_BAR __builtin_amdgcn_s_barrier()
#define PG8_SCHED __builtin_amdgcn_sched_barrier(0)
    Unit cur, nxt; int ui = 0;
    if (!S.next(0, cur)) return;
    f32x4 acc[2][2][4][2];
#pragma unroll
    for (int a = 0; a < 2; ++a)
#pragma unroll
        for (int b = 0; b < 2; ++b)
#pragma unroll
            for (int m = 0; m < 4; ++m)
#pragma unroll
                for (int n = 0; n < 2; ++n) acc[a][b][m][n] = (f32x4){0.f, 0.f, 0.f, 0.f};
    bf16x8 At[4][2], B0[2][2], B1[2][2];
    const char* cAb = (const char*)g.A + (size_t)cur.pm * tstepA;
    const char* cB = (const char*)g.Bt + (size_t)cur.pn * tstepB;
    {
        const char* cA = cAb + AM.koff(0);
        PG8_STAGE(PG8_SB(0, 0), cB, voffB); PG8_STAGE(PG8_SA(0, 0), cA, voffA); PG8_STAGE(PG8_SB(0, 1), cB + hstepB, voffB); PG8_STAGE(PG8_SA(0, 1), cA + hstepA, voffA);
        if (wr == 1) PG8_BAR;
        PG8_WAIT_V(4); PG8_BAR;
        PG8_STAGE(PG8_SB(1, 0), cB + kstep, voffB); PG8_STAGE(PG8_SA(1, 0), cA + kstep, voffA); PG8_STAGE(PG8_SB(1, 1), cB + hstepB + kstep, voffB);
        PG8_WAIT_V(6); PG8_BAR;
    }
    for (;;) {
        const bool has_next = S.next(ui + 1, nxt);
        const char* nAb = has_next ? (const char*)g.A + (size_t)nxt.pm * tstepA : cAb; const char* nB = has_next ? (const char*)g.Bt + (size_t)nxt.pn * tstepB : cB;
        int t = 0;
#pragma unroll 1
        for (int sg = 0; sg < AMap::NSEG; ++sg) {
        const int te = AM.seg_end(sg, nt);
#pragma unroll 1
        for (; t < te; t += 2) {
            const bool last = (t == nt - 2);
            const char* a1 = cAb + AM.koff(t + 1);
            const char* a2 = last ? nAb + AM.koff(0) : cAb + AM.koff(t + 2); const char* b2 = last ? nB : cB + (size_t)(t + 2) * kstep;
            const char* a3 = a2 + kstep; const char* b3 = b2 + kstep;
            PG8_LDB(B0, 0, 0); PG8_SCHED; PG8_LDA(At, 0, 0); PG8_STAGE(PG8_SA(1, 1), a1 + hstepA, voffA);
            PG8_WAIT_L(8); PG8_BAR; PG8_WAIT_L(0); PG8_MMA(0, 0, At, B0); PG8_BAR; PG8_SCHED;
            PG8_LDB(B1, 0, 1); PG8_STAGE(PG8_SB(0, 0), b2, voffB);
            PG8_BAR; PG8_WAIT_L(0); PG8_MMA(0, 1, At, B1); PG8_BAR;
            PG8_LDA(At, 0, 1); PG8_STAGE(PG8_SA(0, 0), a2, voffA);
            PG8_BAR; PG8_WAIT_L(0); PG8_MMA(1, 0, At, B0); PG8_BAR; PG8_SCHED;
            PG8_STAGE(PG8_SB(0, 1), b2 + hstepB, voffB);
            PG8_WAIT_V(6); PG8_BAR; PG8_MMA(1, 1, At, B1); PG8_BAR;
            PG8_LDB(B0, 1, 0); PG8_SCHED; PG8_LDA(At, 1, 0); PG8_STAGE(PG8_SA(0, 1), a2 + hstepA, voffA);
            PG8_WAIT_L(8); PG8_BAR; PG8_WAIT_L(0); PG8_MMA(0, 0, At, B0); PG8_BAR; PG8_SCHED;
            PG8_LDB(B1, 1, 1); PG8_STAGE(PG8_SB(1, 0), b3, voffB);
            PG8_BAR; PG8_WAIT_L(0); PG8_MMA(0, 1, At, B1); PG8_BAR;
            PG8_LDA(At, 1, 1); PG8_STAGE(PG8_SA(1, 0), a3, voffA);
            PG8_BAR; PG8_WAIT_L(0); PG8_MMA(1, 0, At, B0); PG8_BAR; PG8_SCHED;
            PG8_STAGE(PG8_SB(1, 1), b3 + hstepB, voffB);
            PG8_WAIT_V(6); PG8_BAR; PG8_MMA(1, 1, At, B1); PG8_BAR;
        }
        if (AMap::NSEG > 1 && sg + 1 < AMap::NSEG) E.mid(acc, cur, sg, wr, wc, fr, fq);
        }
        E(acc, cur, wr, wc, fr, fq);
        if (!has_next) break;
#pragma unroll
        for (int a = 0; a < 2; ++a)
#pragma unroll
            for (int b = 0; b < 2; ++b)
#pragma unroll
                for (int m = 0; m < 4; ++m)
#pragma unroll
                    for (int n = 0; n < 2; ++n) acc[a][b][m][n] = (f32x4){0.f, 0.f, 0.f, 0.f};
        cur = nxt; cAb = nAb; cB = nB; ++ui;
    }
    PG8_WAIT_V(0);
    if (wr == 0) PG8_BAR;
    PG8_BAR;
#undef PG8_SA
#undef PG8_SB
#undef PG8_STAGE
#undef PG8_LDA
#undef PG8_LDB
#undef PG8_MMA
#undef PG8_WAIT_V
#undef PG8_WAIT_L
#undef PG8_BAR
#undef PG8_SCHED
}
}
using pg8::cvt_pk_bf16;

struct EpiIn1 {
    static constexpr bool PERM = true;
    bf16_t* PA;
    __device__ __forceinline__ void mid(f32x4 (&)[2][2][4][2], const pg8::Unit&, int, int, int, int, int) const {}
    __device__ __forceinline__ void operator()(const f32x4 (&acc)[2][2][4][2], const pg8::Unit& u, int wr, int wc, int fr, int fq) const {
        int row0 = u.pm * 256 + wr * 64 + fr; asm volatile("" : "+v"(row0));
        if (u.pn < 18) {
            const int col0 = u.pn * 256 + wc * 32 + 8 * fq;
#pragma unroll
            for (int ai = 0; ai < 2; ++ai)
#pragma unroll
                for (int m = 0; m < 4; ++m) { bf16_t* rowp = PA + (size_t)(row0 + ai * 128 + m * 16) * NA + col0;
#pragma unroll
                    for (int bj = 0; bj < 2; ++bj) { const f32x4 v0 = acc[ai][bj][m][0], v1 = acc[ai][bj][m][1];
                        u32x4 w; w.x = cvt_pk_bf16(v0[0], v0[1]); w.y = cvt_pk_bf16(v0[2], v0[3]); w.z = cvt_pk_bf16(v1[0], v1[1]); w.w = cvt_pk_bf16(v1[2], v1[3]);
                        *(u32x4*)(rowp + bj * 128) = w; } }
        } else {
            const int ch0 = 64 * (u.pn - 18) + 16 * wc + 4 * fq;
#pragma unroll
            for (int ai = 0; ai < 2; ++ai)
#pragma unroll
                for (int m = 0; m < 4; ++m) { bf16_t* rowp = PA + (size_t)(row0 + ai * 128 + m * 16) * NA;
                    const f32x4 bg = acc[ai][0][m][0], cg = acc[ai][0][m][1], hv = acc[ai][1][m][0], gt = acc[ai][1][m][1];
                    f32x4 uu = cg * hv, ww;
#pragma unroll
                    for (int j = 0; j < 4; ++j) ww[j] = bg[j] * silu_f(gt[j]);
                    u32x2 pu, pw; pu.x = cvt_pk_bf16(uu[0], uu[1]); pu.y = cvt_pk_bf16(uu[2], uu[3]); pw.x = cvt_pk_bf16(ww[0], ww[1]); pw.y = cvt_pk_bf16(ww[2], ww[3]);
                    *(u32x2*)(rowp + PA_U + ch0) = pu; *(u32x2*)(rowp + PA_W + ch0) = pw; }
        }
    }
};
__device__ __forceinline__ int lg_col(int gate, int c) {
    return gate == 0 ? c : (gate == 1 ? PA_XBC + c : (c < 512 ? PA_V + c : PA_XBC + 1024 + (c - 512)));
}
struct EpiIn2 {
    static constexpr bool PERM = true;
    bf16_t* PA;
    __device__ __forceinline__ void mid(f32x4 (&)[2][2][4][2], const pg8::Unit&, int, int, int, int, int) const {}
    __device__ __forceinline__ void operator()(const f32x4 (&acc)[2][2][4][2], const pg8::Unit& u, int wr, int wc, int fr, int fq) const {
        int row0 = u.pm * 256 + wr * 64 + fr; asm volatile("" : "+v"(row0));
        const int gate = u.pn >> 2, cbase = (u.pn & 3) * 256;
#pragma unroll
        for (int ai = 0; ai < 2; ++ai)
#pragma unroll
            for (int m = 0; m < 4; ++m) { bf16_t* rowp = PA + (size_t)(row0 + ai * 128 + m * 16) * NA;
#pragma unroll
                for (int bj = 0; bj < 2; ++bj) { f32x4 v0 = acc[ai][bj][m][0], v1 = acc[ai][bj][m][1];
#pragma unroll
                    for (int j = 0; j < 4; ++j) { v0[j] = 1.0f + __expf(-fminf(fmaxf(v0[j], -30.f), 30.f)); v1[j] = 1.0f + __expf(-fminf(fmaxf(v1[j], -30.f), 30.f)); }
                    u32x4 w; w.x = cvt_pk_bf16(v0[0], v0[1]); w.y = cvt_pk_bf16(v0[2], v0[3]); w.z = cvt_pk_bf16(v1[0], v1[1]); w.w = cvt_pk_bf16(v1[2], v1[3]);
                    const int c = cbase + bj * 128 + wc * 32 + 8 * fq;
                    *(u32x4*)(rowp + lg_col(gate, c)) = w; } }
    }
};
struct EpiMerge {
    static constexpr bool PERM = true;
    const bf16_t* PA; const float* SSQ; bf16_t* MG;
    __device__ __forceinline__ void scale8(f32x4& v0, f32x4& v1, const bf16_t* num, const bf16_t* den, float rs) const {
        const u32x4 dn = *(const u32x4*)den;
        float d[8] = {bflo(dn.x), bfhi(dn.x), bflo(dn.y), bfhi(dn.y), bflo(dn.z), bfhi(dn.z), bflo(dn.w), bfhi(dn.w)};
        float nm[8];
        if (num) { const u32x4 nn = *(const u32x4*)num; nm[0] = bflo(nn.x); nm[1] = bfhi(nn.x); nm[2] = bflo(nn.y); nm[3] = bfhi(nn.y); nm[4] = bflo(nn.z); nm[5] = bfhi(nn.z); nm[6] = bflo(nn.w); nm[7] = bfhi(nn.w); }
        else {
#pragma unroll
            for (int j = 0; j < 8; ++j) nm[j] = 1.0f; }
#pragma unroll
        for (int j = 0; j < 4; ++j) { v0[j] *= rs * nm[j] * __builtin_amdgcn_rcpf(d[j]); v1[j] *= rs * nm[4 + j] * __builtin_amdgcn_rcpf(d[4 + j]); }
    }
    __device__ __forceinline__ void mid(f32x4 (&acc)[2][2][4][2], const pg8::Unit& u, int sg, int wr, int wc, int fr, int fq) const {
        int row0 = u.pm * 256 + wr * 64 + fr; asm volatile("" : "+v"(row0));
#pragma unroll
        for (int ai = 0; ai < 2; ++ai)
#pragma unroll
            for (int m = 0; m < 4; ++m) { const int row = row0 + ai * 128 + m * 16; const bf16_t* rowp = PA + (size_t)row * NA;
                float rs = 1.0f;
                if (sg == 0) { const f32x4* sp = (const f32x4*)(SSQ + (size_t)row * 16); const f32x4 a = sp[0], b = sp[1], c = sp[2], d = sp[3];
                    const float ss = ((a[0] + a[1]) + (a[2] + a[3])) + ((b[0] + b[1]) + (b[2] + b[3])) + ((c[0] + c[1]) + (c[2] + c[3])) + ((d[0] + d[1]) + (d[2] + d[3]));
                    rs = 1.0f / sqrtf(ss * (1.0f / 1024.0f) + EPS); }
#pragma unroll
                for (int bj = 0; bj < 2; ++bj) { const int c = u.pn * 256 + bj * 128 + wc * 32 + 8 * fq;
                    if (sg == 0) scale8(acc[ai][bj][m][0], acc[ai][bj][m][1], rowp + lg_col(0, c), rowp + lg_col(1, c), rs);
                    else         scale8(acc[ai][bj][m][0], acc[ai][bj][m][1], rowp + lg_col(2, c), rowp + lg_col(0, c), 1.0f); }
                asm volatile("" ::: "memory"); }
    }
    __device__ __forceinline__ void operator()(const f32x4 (&acc)[2][2][4][2], const pg8::Unit& u, int wr, int wc, int fr, int fq) const {
        int row0 = u.pm * 256 + wr * 64 + fr; asm volatile("" : "+v"(row0));
#pragma unroll
        for (int ai = 0; ai < 2; ++ai)
#pragma unroll
            for (int m = 0; m < 4; ++m) { const int row = row0 + ai * 128 + m * 16; const bf16_t* rowp = PA + (size_t)row * NA;
#pragma unroll
                for (int bj = 0; bj < 2; ++bj) { const int c = u.pn * 256 + bj * 128 + wc * 32 + 8 * fq;
                    f32x4 v0 = acc[ai][bj][m][0], v1 = acc[ai][bj][m][1];
                    scale8(v0, v1, nullptr, rowp + lg_col(2, c), 1.0f);
                    u32x4 w; w.x = cvt_pk_bf16(v0[0], v0[1]); w.y = cvt_pk_bf16(v0[2], v0[3]); w.z = cvt_pk_bf16(v1[0], v1[1]); w.w = cvt_pk_bf16(v1[2], v1[3]);
                    *(u32x4*)(MG + (size_t)row * 1024 + c) = w; }
                asm volatile("" ::: "memory"); }
    }
};
struct EpiOut {
    static constexpr bool PERM = false;
    const float* xin; float* xout; const float* rgate;
    __device__ __forceinline__ void mid(f32x4 (&)[2][2][4][2], const pg8::Unit&, int, int, int, int, int) const {}
    __device__ __forceinline__ void operator()(const f32x4 (&acc)[2][2][4][2], const pg8::Unit& u, int wr, int wc, int fr, int fq) const {
        int row0 = u.pm * 256 + wr * 64 + fr, col0 = u.pn * 256 + wc * 32 + 4 * fq; asm volatile("" : "+v"(row0), "+v"(col0));
        const float* rg = rgate + (size_t)(u.pm / 8) * 3072 + col0;
        f32x4 gv[2][2];
#pragma unroll
        for (int bj = 0; bj < 2; ++bj)
#pragma unroll
            for (int n = 0; n < 2; ++n) gv[bj][n] = *(const f32x4*)(rg + bj * 128 + n * 16);
#pragma unroll
        for (int ai = 0; ai < 2; ++ai)
#pragma unroll
            for (int m = 0; m < 4; ++m) { const size_t off = (size_t)(row0 + ai * 128 + m * 16) * D + col0;
#pragma unroll
                for (int bj = 0; bj < 2; ++bj)
#pragma unroll
                    for (int n = 0; n < 2; ++n) { const f32x4 xv = *(const f32x4*)(xin + off + bj * 128 + n * 16);
                        *(f32x4*)(xout + off + bj * 128 + n * 16) = xv + gv[bj][n] * acc[ai][bj][m][n]; }
                asm volatile("" ::: "memory"); }
    }
};

struct KArgs { const void* in[19]; float* out; unsigned char* ws; int ph_lo, ph_hi; };
constexpr int ARGS_OFF = RING_BYTES + 512;
enum { I_X = 0, I_C, I_POS, I_NORM_G, I_W_ADA, I_B_ADA, I_W_IN, I_CONV_W, I_CONV_B, I_DT_BIAS, I_A_LOG, I_SSM_D, I_SSM_NORM_G, I_SC_CONV_W, I_W_BR_RET, I_W_BR_SSM, I_W_BR_SC, I_W_OUT, I_FINAL_G };
struct Args { LAS unsigned char* lds; float* out; unsigned char* ws;
    __device__ __forceinline__ const float* f(int i) const { const LAS unsigned* p = (const LAS unsigned*)(lds + ARGS_OFF) + 2 * i;
        const unsigned lo = __builtin_amdgcn_readfirstlane(p[0]), hi = __builtin_amdgcn_readfirstlane(p[1]); return (const float*)(((unsigned long long)hi << 32) | lo); }
};
#define ARGF(name, idx) const float* const name = a.f(idx)

__device__ __forceinline__ int win_srccol(int n) {
    if (n < 4608) return n;
    if (n < N1A) { const int p = (n - 4608) & 255, tt = (n - 4608) >> 8; const int bj = p >> 7, wc = (p >> 5) & 3, fq = (p >> 3) & 3, nn = (p >> 2) & 1, e = p & 3;
        const int q = 2 * bj + nn, ch = 64 * tt + 16 * wc + 4 * fq + e; return C_CB + 512 * q + ch; }
    return C_MG + (n - N1A);
}
template <bool MAP>
__device__ __forceinline__ void transpose_item(const float* W, int ldsrc, int k0, bf16_t* WT, int ldd, int dk0, int n0, const float* scale, LAS float* scr, int lane) {
    const int nsrc = MAP ? win_srccol(n0 + (lane & 31)) : n0 + (lane & 31);
#pragma unroll 8
    for (int i = 0; i < 32; ++i) { const int kk = 2 * i + (lane >> 5); float v = W[(size_t)(k0 + kk) * ldsrc + nsrc]; if (scale) v *= scale[k0 + kk]; scr[kk * 33 + (lane & 31)] = v; }
    LDS_WAIT(); asm volatile("" ::: "memory");
    const int c = lane & 7;
#pragma unroll
    for (int j = 0; j < 4; ++j) { const int n = (lane >> 3) + 8 * j; const LAS float* s = scr + (8 * c) * 33 + n;
        u32x4 o; o.x = pk2(s[0 * 33], s[1 * 33]); o.y = pk2(s[2 * 33], s[3 * 33]); o.z = pk2(s[4 * 33], s[5 * 33]); o.w = pk2(s[6 * 33], s[7 * 33]);
        *(u32x4*)(WT + (size_t)(n0 + n) * ldd + dk0 + 8 * c) = o; }
    LDS_WAIT(); asm volatile("" ::: "memory");
}
__device__ __forceinline__ void convert_weights(const Args& a, int l, LAS unsigned char* lds, int gw, int NGW, int wave, int lane) {
    LAS float* scr = (LAS float*)(lds + wave * 16384);
    bf16_t* WinT = (bf16_t*)(a.ws + WS_WIN); bf16_t* WbrT = (bf16_t*)(a.ws + WS_WBR); bf16_t* WoutT = (bf16_t*)(a.ws + WS_WOUT);
    const float* w_in = a.f(I_W_IN) + (size_t)l * 1024 * IN_W;
    constexpr int I_IN = (NW1 / 32) * 16, I_BR = 32 * 32, I_OUT = 32 * 16;
    for (int it = gw; it < I_IN + I_BR + I_OUT; it += NGW) {
        int r = it;
        if (r < I_IN) { const int nb = r / 16, kb = r % 16; transpose_item<true>(w_in, IN_W, 64 * kb, WinT, 1024, 64 * kb, 32 * nb, nullptr, scr, lane); continue; }
        r -= I_IN;
        if (r < I_BR) { const int nb = r / 32, kb = r % 32;
            if (kb < 16) transpose_item<false>(a.f(I_W_BR_SSM) + (size_t)l * 1024 * 1024, 1024, 64 * kb, WbrT, 2048, 64 * kb, 32 * nb, a.f(I_SSM_NORM_G) + l * 1024, scr, lane);
            else if (kb < 24) transpose_item<false>(a.f(I_W_BR_RET) + (size_t)l * 512 * 1024, 1024, 64 * (kb - 16), WbrT, 2048, 64 * kb, 32 * nb, nullptr, scr, lane);
            else transpose_item<false>(a.f(I_W_BR_SC) + (size_t)l * 512 * 1024, 1024, 64 * (kb - 24), WbrT, 2048, 64 * kb, 32 * nb, nullptr, scr, lane);
            continue; }
        r -= I_BR;
        { const int nb = r / 16, kb = r % 16; transpose_item<false>(a.f(I_W_OUT) + (size_t)l * 1024 * 1024, 1024, 64 * kb, WoutT, 1024, 64 * kb, 32 * nb, nullptr, scr, lane); }
    }
}

__device__ __attribute__((noinline)) void phase_p0(const Args a, LAS unsigned char* lds, int bid, int nblk, int tid, int wave, int lane) {
    float* ada = (float*)(a.ws + WS_ADA);
    LAS float* scs = (LAS float*)lds;
    LAS float* red = (LAS float*)(lds + 32768);
    for (int i = tid; i < 8 * 1024; i += 512) scs[i] = silu_f(a.f(I_C)[i]);
    __syncthreads();
    for (int item = bid; item < 256; item += nblk) {
        const int l = item >> 7, j0 = 24 * (item & 127);
        if (tid < 504) { const int jl = tid % 24, kg = tid / 24; float acc[8];
#pragma unroll
            for (int b = 0; b < 8; ++b) acc[b] = 0.f;
            const float* w = a.f(I_W_ADA) + (size_t)l * 1024 * 3072 + j0 + jl;
            for (int k = kg; k < 1024; k += 21) { const float wv = w[(size_t)k * 3072];
#pragma unroll
                for (int b = 0; b < 8; ++b) acc[b] += scs[b * 1024 + k] * wv; }
#pragma unroll
            for (int b = 0; b < 8; ++b) red[(kg * 24 + jl) * 8 + b] = acc[b]; }
        __syncthreads();
        if (tid < 192) { const int jl = tid >> 3, b = tid & 7; float s = 0.f;
            for (int kg = 0; kg < 21; ++kg) s += red[(kg * 24 + jl) * 8 + b];
            ada[((size_t)l * 8 + b) * 3072 + j0 + jl] = s + a.f(I_B_ADA)[l * 3072 + j0 + jl]; }
        __syncthreads();
    }
    float* cs = (float*)(a.ws + WS_CS);
    for (int idx = bid * 512 + tid; idx < T * 64; idx += nblk * 512) { const int t = idx >> 6, i = idx & 63;
        const float inv_freq = powf(10000.0f, -(float)(2 * i) / 128.0f); const float ang = (float)((const int*)a.f(I_POS))[t] * inv_freq;
        cs[2 * (size_t)idx] = cosf(ang); cs[2 * (size_t)idx + 1] = sinf(ang); }
    __syncthreads();
    convert_weights(a, 0, lds, bid * 8 + wave, nblk * 8, wave, lane);
}

__device__ __attribute__((noinline)) void phase_hprep(const Args a, int l, const float* xcur, LAS unsigned char* lds, int bid, int nblk, int tid, int wave, int lane) {
    if (l > 0) { convert_weights(a, l, lds, bid * 8 + wave, nblk * 8, wave, lane); __syncthreads(); }
    LAS float* wt = (LAS float*)lds;
    const float* w_in = a.f(I_W_IN) + (size_t)l * 1024 * IN_W;
    for (int i = tid; i < 16 * 1024; i += 512) { const int c = i >> 4, j = i & 15; wt[j * 1024 + c] = w_in[(size_t)c * IN_W + C_DT + j]; }
    __syncthreads();
    const float* ada = (const float*)(a.ws + WS_ADA) + (size_t)l * 8 * 3072;
    bf16_t* H = (bf16_t*)(a.ws + WS_H); float* DT = (float*)(a.ws + WS_DT);
    const float* ng = a.f(I_NORM_G) + l * 1024;
    const int gw = bid * 8 + wave, NGW = nblk * 8;
    for (int tok = gw; tok < T; tok += NGW) {
        const int b = tok >> 11;
        const f32x4* xr = (const f32x4*)(xcur + (size_t)tok * D) + lane;
        f32x4 v[4]; float s = 0.f;
#pragma unroll
        for (int j = 0; j < 4; ++j) { v[j] = xr[64 * j]; s += (v[j][0] * v[j][0] + v[j][1] * v[j][1]) + (v[j][2] * v[j][2] + v[j][3] * v[j][3]); }
        const float rstd = 1.0f / sqrtf(wave_sum(s) * (1.0f / D) + EPS);
        const float* shift = ada + (size_t)b * 3072; const float* scale = shift + 1024;
#pragma unroll
        for (int j = 0; j < 4; ++j) { const int c = 4 * lane + 256 * j;
            const f32x4 g = *(const f32x4*)(ng + c), sc = *(const f32x4*)(scale + c), sh = *(const f32x4*)(shift + c);
            v[j] = (v[j] * rstd) * g * (sc + 1.0f) + sh; }
        unsigned long long* o8 = (unsigned long long*)(H + (size_t)tok * D) + lane;
#pragma unroll
        for (int j = 0; j < 4; ++j) o8[64 * j] = (unsigned long long)pk2(v[j][0], v[j][1]) | ((unsigned long long)pk2(v[j][2], v[j][3]) << 32);
        float mine = 0.f;
#pragma unroll 2
        for (int jj = 0; jj < 16; ++jj) { float p = 0.f;
#pragma unroll
            for (int j = 0; j < 4; ++j) { const f32x4 w = *(const LAS f32x4*)(wt + jj * 1024 + 4 * lane + 256 * j); p += (v[j][0] * w[0] + v[j][1] * w[1]) + (v[j][2] * w[2] + v[j][3] * w[3]); }
            p = wave_sum(p); mine = (lane == jj) ? p : mine; }
        if (lane < 16) { const float xv = mine + a.f(I_DT_BIAS)[l * 16 + lane]; DT[(size_t)tok * 16 + lane] = xv > 20.f ? xv : log1pf(__expf(xv)); }
    }
}

__device__ __attribute__((noinline)) void sc_items(const Args a, int l, int vb, int nvb, int tid) {
    bf16_t* PA = (bf16_t*)(a.ws + WS_PA); const float* cw = a.f(I_SC_CONV_W) + (size_t)l * 3 * 512;
    for (int idx = vb * 512 + tid; idx < T * 64; idx += nvb * 512) { const int row = idx >> 6, c0 = (idx & 63) * 8; const int tl = row & (SEQ - 1);
        bf16_t* rp = PA + (size_t)row * NA;
        const u32x4 u2 = *(const u32x4*)(rp + PA_U + c0);
        u32x4 u1 = (u32x4){0u, 0u, 0u, 0u}, u0 = u1;
        if (tl >= 1) u1 = *(const u32x4*)(rp - NA + PA_U + c0);
        if (tl >= 2) u0 = *(const u32x4*)(rp - 2 * NA + PA_U + c0);
        const u32x4 wv = *(const u32x4*)(rp + PA_W + c0);
        float o[8];
#pragma unroll
        for (int j = 0; j < 4; ++j) { const int ca = c0 + 2 * j, cbb = ca + 1;
            o[2 * j] = bflo(wv[j]) * (cw[ca] * bflo(u0[j]) + cw[512 + ca] * bflo(u1[j]) + cw[1024 + ca] * bflo(u2[j]));
            o[2 * j + 1] = bfhi(wv[j]) * (cw[cbb] * bfhi(u0[j]) + cw[512 + cbb] * bfhi(u1[j]) + cw[1024 + cbb] * bfhi(u2[j])); }
        u32x4 r; r.x = pk2(o[0], o[1]); r.y = pk2(o[2], o[3]); r.z = pk2(o[4], o[5]); r.w = pk2(o[6], o[7]);
        *(u32x4*)(rp + PA_W + c0) = r; }
}

typedef short bf16x4 __attribute__((ext_vector_type(4)));
constexpr int LDP = 136;
__device__ __forceinline__ f32x4 mfma16(bf16x8 a, bf16x8 b, f32x4 c) { return __builtin_amdgcn_mfma_f32_16x16x32_bf16(a, b, c, 0, 0, 0); }
__device__ __forceinline__ float bfe(const u32x4 v, int j) { const unsigned w = v[j >> 1]; return (j & 1) ? bfhi(w) : bflo(w); }
__device__ __forceinline__ bf16x8 as_frag(u32x4 v) { return __builtin_bit_cast(bf16x8, v); }
__device__ __forceinline__ float xor16(float v) { return SWZ_XOR(v, 16); }
__device__ __forceinline__ float xor32(float v, int lane) { return __builtin_bit_cast(float, __builtin_amdgcn_ds_bpermute((lane ^ 32) << 2, __builtin_bit_cast(int, v))); }

__device__ __forceinline__ void ret_stage_vt(const bf16_t* PA, size_t row0, int h, LAS bf16_t* Vt, int wave, int lane) {
    const size_t rowA = row0 + 2 * lane;
#pragma unroll
    for (int r = 0; r < 2; ++r) { const int c0 = 8 * (wave + 8 * r);
        const u32x4 va = *(const u32x4*)(PA + rowA * NA + PA_V + 128 * h + c0), vb = *(const u32x4*)(PA + (rowA + 1) * NA + PA_V + 128 * h + c0);
#pragma unroll
        for (int j = 0; j < 8; ++j) { const unsigned a = (va[j >> 1] >> (16 * (j & 1))) & 0xffffu, b = (vb[j >> 1] >> (16 * (j & 1))) & 0xffffu;
            *(LAS unsigned*)(Vt + (c0 + j) * LDP + 2 * lane) = a | (b << 16); } }
}
__device__ __forceinline__ void ret_a_item(const Args a, int item, LAS unsigned char* lds, int tid, int wave, int lane) {
    const bf16_t* PA = (const bf16_t*)(a.ws + WS_PA); const float* CS = (const float*)(a.ws + WS_CS); bf16_t* RS = (bf16_t*)(a.ws + WS_RS);
    const int b = item >> 6, h = (item >> 4) & 3, n = item & 15;
    LAS bf16_t* Kt = (LAS bf16_t*)lds; LAS bf16_t* Vt = Kt + 128 * LDP;
    const size_t row0 = (size_t)b * SEQ + n * 128;
    const float lg = log2f(1.0f - exp2f(-5.0f - (float)h));
    __syncthreads();
    { const int c0 = 8 * wave; const size_t rowA = row0 + 2 * lane;
      const float w0 = exp2f((float)(127 - 2 * lane) * lg), w1 = exp2f((float)(126 - 2 * lane) * lg);
      const u32x4 ka0 = *(const u32x4*)(PA + rowA * NA + PA_K + 128 * h + c0), ka1 = *(const u32x4*)(PA + rowA * NA + PA_K + 128 * h + c0 + 64);
      const u32x4 kb0 = *(const u32x4*)(PA + (rowA + 1) * NA + PA_K + 128 * h + c0), kb1 = *(const u32x4*)(PA + (rowA + 1) * NA + PA_K + 128 * h + c0 + 64);
      const f32x4* ca = (const f32x4*)(CS + (rowA * 64 + c0) * 2); const f32x4* cb = (const f32x4*)(CS + ((rowA + 1) * 64 + c0) * 2);
#pragma unroll
      for (int jj = 0; jj < 4; ++jj) { const f32x4 A4 = ca[jj], B4 = cb[jj];
#pragma unroll
          for (int q = 0; q < 2; ++q) { const int j = 2 * jj + q; const float cA = A4[2 * q], sA = A4[2 * q + 1], cB = B4[2 * q], sB = B4[2 * q + 1];
              const float a1 = bfe(ka0, j), a2 = bfe(ka1, j), b1 = bfe(kb0, j), b2 = bfe(kb1, j);
              *(LAS unsigned*)(Kt + (c0 + j) * LDP + 2 * lane) = pk2((a1 * cA - a2 * sA) * w0, (b1 * cB - b2 * sB) * w1);
              *(LAS unsigned*)(Kt + (c0 + 64 + j) * LDP + 2 * lane) = pk2((a1 * sA + a2 * cA) * w0, (b1 * sB + b2 * cB) * w1); } } }
    ret_stage_vt(PA, row0, h, Vt, wave, lane);
    __syncthreads();
    const int fr = lane & 15, fq = lane >> 4;
    bf16x8 Af[4];
#pragma unroll
    for (int ks = 0; ks < 4; ++ks) Af[ks] = *(const LAS bf16x8*)(Kt + (16 * wave + fr) * LDP + 32 * ks + 8 * fq);
    bf16_t* outp = RS + (size_t)item * 16384;
#pragma unroll
    for (int eb = 0; eb < 8; ++eb) { f32x4 acc = (f32x4){0.f, 0.f, 0.f, 0.f};
#pragma unroll
        for (int ks = 0; ks < 4; ++ks) acc = mfma16(Af[ks], *(const LAS bf16x8*)(Vt + (16 * eb + fr) * LDP + 32 * ks + 8 * fq), acc);
        u32x2 o; o.x = pk2(acc[0], acc[1]); o.y = pk2(acc[2], acc[3]);
        *(u32x2*)(outp + (16 * eb + fr) * 128 + 16 * wave + 4 * fq) = o; }
}
__device__ __forceinline__ void ret_scan(const Args a, int gtid, int gthreads) {
    bf16_t* RS = (bf16_t*)(a.ws + WS_RS);
    for (int idx = gtid; idx < 32 * 4096; idx += gthreads) { const int bh = idx >> 12, unit = idx & 4095, h = bh & 3;
        const float cd = exp2f(128.0f * log2f(1.0f - exp2f(-5.0f - (float)h)));
        u32x2* p = (u32x2*)(RS + (size_t)bh * 16 * 16384 + unit * 4);
        u32x2 v[16];
#pragma unroll
        for (int n = 0; n < 16; ++n) v[n] = p[(size_t)n * 4096];
        float s0 = 0.f, s1 = 0.f, s2 = 0.f, s3 = 0.f;
#pragma unroll
        for (int n = 0; n < 16; ++n) { u32x2 o; o.x = pk2(s0, s1); o.y = pk2(s2, s3); p[(size_t)n * 4096] = o;
            s0 = cd * s0 + bflo(v[n].x); s1 = cd * s1 + bfhi(v[n].x); s2 = cd * s2 + bflo(v[n].y); s3 = cd * s3 + bfhi(v[n].y); } }
}
__device__ __attribute__((noinline)) void retb_stage(const Args a, int item, LAS unsigned char* lds, int tid, int wave, int lane) {
    item = __builtin_amdgcn_readfirstlane(item); wave = __builtin_amdgcn_readfirstlane(wave);
    const bf16_t* PA = (const bf16_t*)(a.ws + WS_PA); const float* CS = (const float*)(a.ws + WS_CS); const bf16_t* RS = (const bf16_t*)(a.ws + WS_RS);
    const int b = item >> 6, h = (item >> 4) & 3, n = item & 15;
    LAS bf16_t* Kn = (LAS bf16_t*)lds; LAS bf16_t* Vt = Kn + 128 * LDP; LAS bf16_t* St = Vt + 128 * LDP;
    const size_t row0 = (size_t)b * SEQ + n * 128;
    __syncthreads();
#pragma unroll
    for (int r = 0; r < 2; ++r) { const int task = tid + 512 * r, tok = task >> 3, c0 = 8 * (task & 7); const size_t row = row0 + tok;
        const u32x4 k0 = *(const u32x4*)(PA + row * NA + PA_K + 128 * h + c0), k1 = *(const u32x4*)(PA + row * NA + PA_K + 128 * h + c0 + 64);
        const f32x4* cp = (const f32x4*)(CS + (row * 64 + c0) * 2);
        u32x4 o0, o1;
#pragma unroll
        for (int jj = 0; jj < 4; ++jj) { const f32x4 c4 = cp[jj];
            const float x1a = bfe(k0, 2 * jj), x2a = bfe(k1, 2 * jj), x1b = bfe(k0, 2 * jj + 1), x2b = bfe(k1, 2 * jj + 1);
            o0[jj] = pk2(x1a * c4[0] - x2a * c4[1], x1b * c4[2] - x2b * c4[3]); o1[jj] = pk2(x1a * c4[1] + x2a * c4[0], x1b * c4[3] + x2b * c4[2]); }
        *(LAS u32x4*)(Kn + tok * LDP + c0) = o0; *(LAS u32x4*)(Kn + tok * LDP + c0 + 64) = o1; asm volatile("" ::: "memory"); }
    ret_stage_vt(PA, row0, h, Vt, wave, lane); asm volatile("" ::: "memory");
    { const bf16_t* sp = RS + (size_t)item * 16384;
#pragma unroll
      for (int r = 0; r < 4; ++r) { const int idx = tid + 512 * r, e = idx >> 4, c = idx & 15; *(LAS u32x4*)(St + e * LDP + 8 * c) = *(const u32x4*)(sp + e * 128 + 8 * c); } }
    __syncthreads();
}
__device__ __attribute__((noinline)) void retb_compute(const Args a, int item, LAS unsigned char* lds, int tid, int wave, int lane) {
    item = __builtin_amdgcn_readfirstlane(item); wave = __builtin_amdgcn_readfirstlane(wave);
    bf16_t* PA = (bf16_t*)(a.ws + WS_PA); const float* CS = (const float*)(a.ws + WS_CS);
    const int b = item >> 6, h = (item >> 4) & 3, n = item & 15;
    const LAS bf16_t* Kn = (const LAS bf16_t*)lds; const LAS bf16_t* Vt = Kn + 128 * LDP; const LAS bf16_t* St = Vt + 128 * LDP;
    const size_t row0 = (size_t)b * SEQ + n * 128;
    const float lg = log2f(1.0f - exp2f(-5.0f - (float)h));
    const int fr = lane & 15, fq = lane >> 4;
    const int iq = 16 * wave + fr; const size_t rowq = row0 + iq;
    u32x4 Qf[4];
    { u32x4 q[4];
#pragma unroll
      for (int ks = 0; ks < 4; ++ks) q[ks] = *(const u32x4*)(PA + rowq * NA + PA_Q + 128 * h + 32 * ks + 8 * fq);
      const float qs = 0.08838834764831845f;
#pragma unroll
      for (int ks = 0; ks < 2; ++ks) { const f32x4* cp = (const f32x4*)(CS + (rowq * 64 + 32 * ks + 8 * fq) * 2);
#pragma unroll
          for (int jj = 0; jj < 4; ++jj) { const f32x4 c4 = cp[jj];
              const float x1a = bfe(q[ks], 2 * jj), x2a = bfe(q[ks + 2], 2 * jj), x1b = bfe(q[ks], 2 * jj + 1), x2b = bfe(q[ks + 2], 2 * jj + 1);
              Qf[ks][jj] = pk2((x1a * c4[0] - x2a * c4[1]) * qs, (x1b * c4[2] - x2b * c4[3]) * qs);
              Qf[ks + 2][jj] = pk2((x1a * c4[1] + x2a * c4[0]) * qs, (x1b * c4[3] + x2b * c4[2]) * qs); } } }
    u32x4 P[4];
#pragma unroll
    for (int kk = 0; kk < 4; ++kk) P[kk] = (u32x4){0u, 0u, 0u, 0u};
#pragma unroll
    for (int jb = 0; jb < 8; ++jb) {
        if (jb <= wave) { f32x4 acc = (f32x4){0.f, 0.f, 0.f, 0.f};
#pragma unroll
            for (int ks = 0; ks < 4; ++ks) acc = mfma16(*(const LAS bf16x8*)(Kn + (16 * jb + fr) * LDP + 32 * ks + 8 * fq), as_frag(Qf[ks]), acc);
            float v[4];
#pragma unroll
            for (int r = 0; r < 4; ++r) { const int dij = iq - (16 * jb + 4 * fq + r); v[r] = dij >= 0 ? acc[r] * exp2f((float)dij * lg) : 0.f; }
            P[jb >> 1][(jb & 1) * 2] = pk2(v[0], v[1]); P[jb >> 1][(jb & 1) * 2 + 1] = pk2(v[2], v[3]); }
        asm volatile("" ::: "memory"); }
    { const float gi = exp2f((float)(iq + 1) * lg);
#pragma unroll
      for (int ks = 0; ks < 4; ++ks)
#pragma unroll
          for (int jj = 0; jj < 4; ++jj) Qf[ks][jj] = pk2(bflo(Qf[ks][jj]) * gi, bfhi(Qf[ks][jj]) * gi); }
    const int nkk = (wave + 2) >> 1;
    f32x4 o[8]; float s1 = 0.f;
#pragma unroll
    for (int eb = 0; eb < 8; ++eb) { f32x4 acc = (f32x4){0.f, 0.f, 0.f, 0.f};
#pragma unroll
        for (int ks = 0; ks < 4; ++ks) acc = mfma16(*(const LAS bf16x8*)(St + (16 * eb + fr) * LDP + 32 * ks + 8 * fq), as_frag(Qf[ks]), acc);
#pragma unroll
        for (int kk = 0; kk < 4; ++kk) if (kk < nkk) { const LAS bf16_t* vp = Vt + (16 * eb + fr) * LDP + 32 * kk + 4 * fq;
            const u32x2 lo = *(const LAS u32x2*)vp, hi = *(const LAS u32x2*)(vp + 16);
            acc = mfma16(as_frag((u32x4){lo.x, lo.y, hi.x, hi.y}), as_frag(P[kk]), acc); }
        o[eb] = acc; s1 += (acc[0] + acc[1]) + (acc[2] + acc[3]); asm volatile("" ::: "memory"); }
    s1 += xor16(s1); s1 += xor32(s1, lane);
    const float mean = s1 * (1.0f / 128.0f); float s2 = 0.f;
#pragma unroll
    for (int eb = 0; eb < 8; ++eb) { const f32x4 d = o[eb] - mean; s2 += (d[0] * d[0] + d[1] * d[1]) + (d[2] * d[2] + d[3] * d[3]); }
    s2 += xor16(s2); s2 += xor32(s2, lane);
    const float rstd = 1.0f / sqrtf(s2 * (1.0f / 128.0f) + EPS);
    bf16_t* gp = PA + rowq * NA + PA_G + 128 * h + 4 * fq;
#pragma unroll
    for (int eb = 0; eb < 8; ++eb) { const u32x2 g = *(const u32x2*)(gp + 16 * eb);
        const float y0 = (o[eb][0] - mean) * rstd * silu_f(bflo(g.x)), y1 = (o[eb][1] - mean) * rstd * silu_f(bfhi(g.x));
        const float y2 = (o[eb][2] - mean) * rstd * silu_f(bflo(g.y)), y3 = (o[eb][3] - mean) * rstd * silu_f(bfhi(g.y));
        u32x2 w; w.x = pk2(y0, y1); w.y = pk2(y2, y3); *(u32x2*)(gp + 16 * eb) = w; asm volatile("" ::: "memory"); }
}

constexpr int SSD_T0 = 104448, SSD_T1 = 108544;
constexpr int SSD_WT = 112640;
__device__ __forceinline__ void ssd_stage_wtab(const float* cw, const float* cb, int g, LAS unsigned char* lds, int tid) {
    LAS float* wt = (LAS float*)(lds + SSD_WT);
    for (int i = tid; i < 5 * 768; i += 512) { const int k = i / 768, ci = i - 768 * k; const int ch = ci < 512 ? 512 * g + ci : (ci < 640 ? 1024 + 128 * g + (ci - 512) : 1280 + 128 * g + (ci - 640));
        wt[i] = k < 4 ? cw[k * 1536 + ch] : cb[ch]; }
}
__device__ __forceinline__ void conv8(const bf16_t* PA, size_t row, int seqpos, int ch0, int ci0, const LAS unsigned char* lds, float (&out)[8]) {
    const LAS float* wt = (const LAS float*)(lds + SSD_WT) + ci0;
    { const f32x4 b0 = *(const LAS f32x4*)(wt + 4 * 768), b1 = *(const LAS f32x4*)(wt + 4 * 768 + 4);
#pragma unroll
      for (int j = 0; j < 4; ++j) { out[j] = b0[j]; out[4 + j] = b1[j]; } }
#pragma unroll
    for (int k = 0; k < 4; ++k) { u32x4 r = (u32x4){0u, 0u, 0u, 0u}; if (seqpos - 3 + k >= 0) r = *(const u32x4*)(PA + (row - 3 + k) * NA + PA_XBC + ch0);
        const f32x4 w0 = *(const LAS f32x4*)(wt + k * 768), w1 = *(const LAS f32x4*)(wt + k * 768 + 4);
#pragma unroll
        for (int j = 0; j < 4; ++j) { out[j] += w0[j] * bfe(r, j); out[4 + j] += w1[j] * bfe(r, 4 + j); } }
#pragma unroll
    for (int j = 0; j < 8; ++j) out[j] = silu_f(out[j]);
}
template <int MODE>
__device__ __forceinline__ void ssd_tables(const Args a, int l, int b, int c, int g, LAS unsigned char* lds, int wave, int lane) {
    const float* DT = (const float*)(a.ws + WS_DT);
    LAS float* cst = (LAS float*)(lds + SSD_T0); LAS float* t1 = (LAS float*)(lds + SSD_T1);
    const int head = 8 * g + wave; const size_t row0 = (size_t)b * SEQ + 128 * c;
    const float A = -__expf(a.f(I_A_LOG)[l * 16 + head]);
    const float dt0 = DT[(row0 + 2 * lane) * 16 + head], dt1 = DT[(row0 + 2 * lane + 1) * 16 + head];
    const float a0 = dt0 * A, a1 = dt1 * A, s = a0 + a1;
    float v = s;
#pragma unroll
    for (int d = 1; d < 64; d <<= 1) { const float t = __builtin_bit_cast(float, __builtin_amdgcn_ds_bpermute((lane - d) << 2, __builtin_bit_cast(int, v))); if (lane >= d) v += t; }
    const float ex = v - s, cs0 = ex + a0, cs1 = ex + s;
    const float total = __builtin_bit_cast(float, __builtin_amdgcn_readlane(__builtin_bit_cast(int, v), 63));
    cst[wave * 128 + 2 * lane] = cs0; cst[wave * 128 + 2 * lane + 1] = cs1;
    if (MODE == 0) { t1[wave * 128 + 2 * lane] = dt0 * __expf(total - cs0); t1[wave * 128 + 2 * lane + 1] = dt1 * __expf(total - cs1);
        if (lane == 0) ((float*)(a.ws + WS_CD))[((size_t)b * 16 + c) * 16 + head] = __expf(total); }
    else { t1[wave * 128 + 2 * lane] = dt0; t1[wave * 128 + 2 * lane + 1] = dt1; }
}
__device__ __attribute__((noinline)) void ssda_prep(const Args a, int l, int item, LAS unsigned char* lds, int tid, int wave, int lane) {
    item = __builtin_amdgcn_readfirstlane(item); wave = __builtin_amdgcn_readfirstlane(wave); l = __builtin_amdgcn_readfirstlane(l);
    const int b = item >> 5, c = (item >> 1) & 15, g = item & 1;
    const bf16_t* PA = (const bf16_t*)(a.ws + WS_PA);
    const float* cw = a.f(I_CONV_W) + (size_t)l * 4 * 1536; const float* cb = a.f(I_CONV_B) + (size_t)l * 1536;
    LAS bf16_t* Bt = (LAS bf16_t*)lds;
    const size_t row0 = (size_t)b * SEQ + 128 * c;
    __syncthreads();
    ssd_stage_wtab(cw, cb, g, lds, tid);
    ssd_tables<0>(a, l, b, c, g, lds, wave, lane);
    __syncthreads();
#pragma unroll 1
    for (int q = 4 * wave; q < 4 * wave + 4; ++q) { const int blk = q >> 1, tok = 64 * (q & 1) + lane; float o[8];
        conv8(PA, row0 + tok, 128 * c + tok, 1024 + 128 * g + 8 * blk, 512 + 8 * blk, lds, o);
#pragma unroll
        for (int j = 0; j < 8; ++j) Bt[(8 * blk + j) * LDP + tok] = (bf16_t)f2bf(o[j]); }
}
__device__ __attribute__((noinline)) void ssda_half(const Args a, int l, int item, int half, LAS unsigned char* lds, int tid, int wave, int lane) {
    item = __builtin_amdgcn_readfirstlane(item); wave = __builtin_amdgcn_readfirstlane(wave); l = __builtin_amdgcn_readfirstlane(l); half = __builtin_amdgcn_readfirstlane(half);
    const int b = item >> 5, c = (item >> 1) & 15, g = item & 1;
    const bf16_t* PA = (const bf16_t*)(a.ws + WS_PA); bf16_t* SS = (bf16_t*)(a.ws + WS_SS);
    const LAS bf16_t* Bt = (const LAS bf16_t*)lds; LAS bf16_t* xwt = (LAS bf16_t*)(lds + 34816); const LAS float* wt = (const LAS float*)(lds + SSD_T1);
    const size_t row0 = (size_t)b * SEQ + 128 * c;
    __syncthreads();
#pragma unroll 1
    for (int q = 8 * wave; q < 8 * wave + 8; ++q) { const int blk = q >> 1, tok = 64 * (q & 1) + lane, hh = 4 * half + (blk >> 3); float o[8];
        conv8(PA, row0 + tok, 128 * c + tok, 64 * (8 * g + hh) + 8 * (blk & 7), 64 * hh + 8 * (blk & 7), lds, o);
        const float w = wt[hh * 128 + tok];
#pragma unroll
        for (int j = 0; j < 8; ++j) xwt[(8 * blk + j) * LDP + tok] = (bf16_t)f2bf(o[j] * w); }
    __syncthreads();
    const int fr = lane & 15, fq = lane >> 4;
    bf16x8 Bf[2][4];
#pragma unroll
    for (int pp = 0; pp < 2; ++pp)
#pragma unroll
        for (int ks = 0; ks < 4; ++ks) Bf[pp][ks] = *(const LAS bf16x8*)(xwt + (32 * wave + 16 * pp + fr) * LDP + 32 * ks + 8 * fq);
    const int head = 8 * g + 4 * half + (wave >> 1);
    bf16_t* outp = SS + (((size_t)b * 16 + c) * 16 + head) * 8192;
#pragma unroll 2
    for (int nb = 0; nb < 8; ++nb) { bf16x8 Af[4];
#pragma unroll
        for (int ks = 0; ks < 4; ++ks) Af[ks] = *(const LAS bf16x8*)(Bt + (16 * nb + fr) * LDP + 32 * ks + 8 * fq);
#pragma unroll
        for (int pp = 0; pp < 2; ++pp) { f32x4 acc = (f32x4){0.f, 0.f, 0.f, 0.f};
#pragma unroll
            for (int ks = 0; ks < 4; ++ks) acc = mfma16(Af[ks], Bf[pp][ks], acc);
            u32x2 o; o.x = pk2(acc[0], acc[1]); o.y = pk2(acc[2], acc[3]);
            *(u32x2*)(outp + ((32 * wave + 16 * pp + fr) & 63) * 128 + 16 * nb + 4 * fq) = o; } }
}
__device__ __forceinline__ void ssd_scan(const Args a, int gtid, int gthreads) {
    bf16_t* SS = (bf16_t*)(a.ws + WS_SS); const float* CD = (const float*)(a.ws + WS_CD);
    for (int idx = gtid; idx < 8 * 16 * 2048; idx += gthreads) { const int bb = idx >> 15, head = (idx >> 11) & 15, unit = idx & 2047;
        u32x2* p = (u32x2*)(SS + ((size_t)bb * 256 + head) * 8192 + unit * 4);
        const float* cdp = CD + (size_t)bb * 256 + head;
        u32x2 v[16]; float cd[16];
#pragma unroll
        for (int c = 0; c < 16; ++c) { v[c] = p[(size_t)c * 16 * 2048]; cd[c] = cdp[c * 16]; }
        float s0 = 0.f, s1 = 0.f, s2 = 0.f, s3 = 0.f;
#pragma unroll
        for (int c = 0; c < 16; ++c) { u32x2 o; o.x = pk2(s0, s1); o.y = pk2(s2, s3); p[(size_t)c * 16 * 2048] = o;
            s0 = cd[c] * s0 + bflo(v[c].x); s1 = cd[c] * s1 + bfhi(v[c].x); s2 = cd[c] * s2 + bflo(v[c].y); s3 = cd[c] * s3 + bfhi(v[c].y); } }
}
__device__ __attribute__((noinline)) void ssdb_prep(const Args a, int l, int item, LAS unsigned char* lds, int tid, int wave, int lane) {
    item = __builtin_amdgcn_readfirstlane(item); wave = __builtin_amdgcn_readfirstlane(wave); l = __builtin_amdgcn_readfirstlane(l);
    const int b = item >> 5, c = (item >> 1) & 15, g = item & 1;
    const bf16_t* PA = (const bf16_t*)(a.ws + WS_PA);
    const float* cw = a.f(I_CONV_W) + (size_t)l * 4 * 1536; const float* cb = a.f(I_CONV_B) + (size_t)l * 1536;
    LAS bf16_t* Bn = (LAS bf16_t*)lds;
    const size_t row0 = (size_t)b * SEQ + 128 * c;
    __syncthreads();
    ssd_stage_wtab(cw, cb, g, lds, tid);
    ssd_tables<1>(a, l, b, c, g, lds, wave, lane);
    __syncthreads();
#pragma unroll 1
    for (int q = 8 * wave; q < 8 * wave + 8; ++q) { const int blk = q >> 1, tok = 64 * (q & 1) + lane; float o[8];
        conv8(PA, row0 + tok, 128 * c + tok, (blk < 16 ? 1024 : 1280 - 128) + 128 * g + 8 * blk, 512 + 8 * blk, lds, o);
        u32x4 w; w.x = pk2(o[0], o[1]); w.y = pk2(o[2], o[3]); w.z = pk2(o[4], o[5]); w.w = pk2(o[6], o[7]);
        *(LAS u32x4*)(Bn + ((blk >> 4) * 128 + tok) * LDP + 8 * (blk & 15)) = w; }
}
__device__ __attribute__((noinline)) void ssdb_gt(LAS unsigned char* lds, int tid, int wave, int lane) {
    wave = __builtin_amdgcn_readfirstlane(wave);
    const LAS bf16_t* Bn = (const LAS bf16_t*)lds; const LAS bf16_t* Cn = Bn + 128 * LDP;
    const int fr = lane & 15, fq = lane >> 4;
    __syncthreads();
    u32x2 GT[8];
    bf16x8 Cf[4];
#pragma unroll
    for (int ks = 0; ks < 4; ++ks) Cf[ks] = *(const LAS bf16x8*)(Cn + (16 * wave + fr) * LDP + 32 * ks + 8 * fq);
#pragma unroll
    for (int sb = 0; sb < 8; ++sb) { f32x4 acc = (f32x4){0.f, 0.f, 0.f, 0.f};
        if (sb <= wave) {
#pragma unroll
            for (int ks = 0; ks < 4; ++ks) acc = mfma16(*(const LAS bf16x8*)(Bn + (16 * sb + fr) * LDP + 32 * ks + 8 * fq), Cf[ks], acc); }
        GT[sb].x = pk2(acc[0], acc[1]); GT[sb].y = pk2(acc[2], acc[3]); }
    __syncthreads();
#pragma unroll
    for (int sb = 0; sb < 8; ++sb) *(LAS u32x2*)(lds + (sb * 512 + tid) * 8) = GT[sb];
}
__device__ __attribute__((noinline)) void ssdb_head(const Args a, int l, int item, int hh, LAS unsigned char* lds, int tid, int wave, int lane) {
    item = __builtin_amdgcn_readfirstlane(item); wave = __builtin_amdgcn_readfirstlane(wave); l = __builtin_amdgcn_readfirstlane(l); hh = __builtin_amdgcn_readfirstlane(hh);
    const int b = item >> 5, c = (item >> 1) & 15, g = item & 1, head = 8 * g + hh;
    bf16_t* PA = (bf16_t*)(a.ws + WS_PA); const bf16_t* SS = (const bf16_t*)(a.ws + WS_SS); float* SSQ = (float*)(a.ws + WS_SSQ);
    const LAS bf16_t* Cn = (const LAS bf16_t*)lds + 128 * LDP; LAS bf16_t* xt = (LAS bf16_t*)(lds + 69632); LAS bf16_t* Hh = (LAS bf16_t*)(lds + 87040);
    const LAS float* cst = (const LAS float*)(lds + SSD_T0); const LAS float* dtt = (const LAS float*)(lds + SSD_T1);
    const size_t row0 = (size_t)b * SEQ + 128 * c;
    const int fr = lane & 15, fq = lane >> 4, lcol = 16 * wave + fr; const size_t rowl = row0 + lcol;
    const int nkk = (wave + 2) >> 1;
    __syncthreads();
#pragma unroll 1
    for (int q = 2 * wave; q < 2 * wave + 2; ++q) { const int blk = q >> 1, tok = 64 * (q & 1) + lane; float o[8];
        conv8(PA, row0 + tok, 128 * c + tok, 64 * head + 8 * blk, 64 * hh + 8 * blk, lds, o);
#pragma unroll
        for (int j = 0; j < 8; ++j) xt[(8 * blk + j) * LDP + tok] = (bf16_t)f2bf(o[j]); }
    { const bf16_t* sp = SS + (((size_t)b * 16 + c) * 16 + head) * 8192;
#pragma unroll
      for (int r = 0; r < 2; ++r) { const int idx = tid + 512 * r, p = idx >> 4, cc = idx & 15; *(LAS u32x4*)(Hh + p * LDP + 8 * cc) = *(const u32x4*)(sp + p * 128 + 8 * cc); } }
    __syncthreads();
    const float csl = cst[hh * 128 + lcol], ecl = __expf(csl), Dh = a.f(I_SSM_D)[l * 16 + head];
    u32x4 Pm[4];
#pragma unroll
    for (int kk = 0; kk < 4; ++kk) Pm[kk] = (u32x4){0u, 0u, 0u, 0u};
#pragma unroll
    for (int sb = 0; sb < 8; ++sb) {
        if (sb <= wave) { const f32x4 cs4 = *(const LAS f32x4*)(cst + hh * 128 + 16 * sb + 4 * fq), dt4 = *(const LAS f32x4*)(dtt + hh * 128 + 16 * sb + 4 * fq);
            const u32x2 gp = *(const LAS u32x2*)(lds + (sb * 512 + tid) * 8);
            const float gt[4] = {bflo(gp.x), bfhi(gp.x), bflo(gp.y), bfhi(gp.y)};
            float v[4];
#pragma unroll
            for (int r = 0; r < 4; ++r) { const int sidx = 16 * sb + 4 * fq + r; v[r] = sidx <= lcol ? gt[r] * __expf(csl - cs4[r]) * dt4[r] : 0.f; }
            Pm[sb >> 1][(sb & 1) * 2] = pk2(v[0], v[1]); Pm[sb >> 1][(sb & 1) * 2 + 1] = pk2(v[2], v[3]); } }
    float ssq = 0.f;
    bf16_t* zp = PA + rowl * NA + PA_Z + 64 * head + 4 * fq;
#pragma unroll
    for (int pb = 0; pb < 4; ++pb) { f32x4 yd = (f32x4){0.f, 0.f, 0.f, 0.f}, yo = (f32x4){0.f, 0.f, 0.f, 0.f};
#pragma unroll
        for (int kk = 0; kk < 4; ++kk) if (kk < nkk) { const LAS bf16_t* vp = xt + (16 * pb + fr) * LDP + 32 * kk + 4 * fq;
            const u32x2 lo = *(const LAS u32x2*)vp, hi = *(const LAS u32x2*)(vp + 16);
            yd = mfma16(as_frag((u32x4){lo.x, lo.y, hi.x, hi.y}), as_frag(Pm[kk]), yd); }
#pragma unroll
        for (int ks = 0; ks < 4; ++ks) yo = mfma16(*(const LAS bf16x8*)(Hh + (16 * pb + fr) * LDP + 32 * ks + 8 * fq), *(const LAS bf16x8*)(Cn + (16 * wave + fr) * LDP + 32 * ks + 8 * fq), yo);
        const u32x2 z = *(const u32x2*)(zp + 16 * pb);
        float y[4];
#pragma unroll
        for (int r = 0; r < 4; ++r) y[r] = yd[r] + ecl * yo[r] + Dh * bf2f(xt[(16 * pb + 4 * fq + r) * LDP + lcol]);
        y[0] *= silu_f(bflo(z.x)); y[1] *= silu_f(bfhi(z.x)); y[2] *= silu_f(bflo(z.y)); y[3] *= silu_f(bfhi(z.y));
        ssq += (y[0] * y[0] + y[1] * y[1]) + (y[2] * y[2] + y[3] * y[3]);
        u32x2 w; w.x = pk2(y[0], y[1]); w.y = pk2(y[2], y[3]); *(u32x2*)(zp + 16 * pb) = w;
        asm volatile("" ::: "memory"); }
    ssq += xor16(ssq); ssq += xor32(ssq, lane);
    if (fq == 0) SSQ[rowl * 16 + head] = ssq;
}
__device__ __attribute__((noinline)) void phase_mix_a(const Args a, int l, LAS unsigned char* lds, int bid, int nblk, int tid, int wave, int lane) {
    bid = __builtin_amdgcn_readfirstlane(bid); nblk = __builtin_amdgcn_readfirstlane(nblk); wave = __builtin_amdgcn_readfirstlane(wave);
    for (int item = bid; item < 512; item += nblk) ret_a_item(a, item, lds, tid, wave, lane);
}
__device__ __attribute__((noinline)) void phase_mix_scan(const Args a, int l, LAS unsigned char* lds, int bid, int nblk, int tid, int wave, int lane) {
    ret_scan(a, bid * 512 + tid, nblk * 512);
    ssd_scan(a, bid * 512 + tid, nblk * 512);
}
__device__ __attribute__((noinline)) void phase_final(const Args a, int bid, int nblk, int wave, int lane) {
    const int gw = bid * 8 + wave, NGW = nblk * 8;
    for (int tok = gw; tok < T; tok += NGW) {
        f32x4* xr = (f32x4*)(a.out + (size_t)tok * D) + lane;
        f32x4 v[4]; float s = 0.f;
#pragma unroll
        for (int j = 0; j < 4; ++j) { v[j] = xr[64 * j]; s += (v[j][0] * v[j][0] + v[j][1] * v[j][1]) + (v[j][2] * v[j][2] + v[j][3] * v[j][3]); }
        const float rstd = 1.0f / sqrtf(wave_sum(s) * (1.0f / D) + EPS);
#pragma unroll
        for (int j = 0; j < 4; ++j) { const f32x4 g = *(const f32x4*)(a.f(I_FINAL_G) + 4 * lane + 256 * j); xr[64 * j] = (v[j] * rstd) * g; }
    }
}

constexpr int NPHASE = 18;
__global__ void __launch_bounds__(512, 2) mk_fwd(KArgs ka) {
    extern __shared__ __attribute__((aligned(16))) unsigned char lds_raw[];
    LAS unsigned char* lds = (LAS unsigned char*)lds_raw;
    const int tid0 = threadIdx.x, wave = __builtin_amdgcn_readfirstlane(tid0 >> 6);
    const int bid = blockIdx.x, nblk = gridDim.x;
    volatile LAS unsigned* MISC = (volatile LAS unsigned*)(lds + MISC_OFF);
    for (int u = tid0; u < (LDS_BYTES - RING_BYTES) / 4; u += 512) ((LAS unsigned*)(lds + RING_BYTES))[u] = 0u;
    __syncthreads();
    if (tid0 == 0) {
#pragma unroll
        for (int i = 0; i < 19; ++i) { const unsigned long long v = (unsigned long long)ka.in[i]; ((LAS unsigned*)(lds + ARGS_OFF))[2 * i] = (unsigned)v; ((LAS unsigned*)(lds + ARGS_OFF))[2 * i + 1] = (unsigned)(v >> 32); } }
    __syncthreads();
    unsigned* ctl = (unsigned*)(ka.ws + WS_CTL);
    XcdBarrier bar; bar.bar = ctl + CW_BAR; bar.x = 0; bar.st = nullptr;
    if (!MK_SPLIT) bar = xcd_barrier_post(ctl + CW_BAR, MISC + 8);
    const int lo = ka.ph_lo, hi = ka.ph_hi;
#pragma unroll 1
    for (int ph = lo; ph < hi; ++ph) {
        int tid = tid0; asm volatile("" : "+v"(tid)); const int lane = tid & 63;
        Args a; a.lds = lds; a.out = ka.out; a.ws = ka.ws; asm volatile("" : "+s"(a.ws), "+s"(a.out));
        bf16_t* PA = (bf16_t*)(a.ws + WS_PA); bf16_t* H = (bf16_t*)(a.ws + WS_H);
        const bf16_t* WinT = (const bf16_t*)(a.ws + WS_WIN); const bf16_t* WbrT = (const bf16_t*)(a.ws + WS_WBR); const bf16_t* WoutT = (const bf16_t*)(a.ws + WS_WOUT);
        const int l = ph >= 9 ? 1 : 0, k = ph - 1 - 8 * l;
        const float* xcur = l == 0 ? a.f(I_X) : a.out;
        if (ph == 0) { phase_p0(a, lds, bid, nblk, tid, wave, lane); }
        else if (ph == 17) { phase_final(a, bid, nblk, wave, lane); }
        else if (k == 0) { phase_hprep(a, l, xcur, lds, bid, nblk, tid, wave, lane); }
        else if (k == 1) { pg8::Gemm g{H, 1024, WinT, T, N1A, 1024}; pg8::StaticOrder S; S.init(T, N1A, nblk, bid); EpiIn1 E{PA}; pg8::gemm_phase(lds, g, S, E, pg8::AMapLinear{}); }
        else if (k == 2) { phase_mix_a(a, l, lds, bid, nblk, tid, wave, lane);
            for (int item = bid; item < 256; item += nblk) { ssda_prep(a, l, item, lds, tid, wave, lane); ssda_half(a, l, item, 0, lds, tid, wave, lane); ssda_half(a, l, item, 1, lds, tid, wave, lane); } }
        else if (k == 3) { phase_mix_scan(a, l, lds, bid, nblk, tid, wave, lane); }
        else if (k == 4) {
            sc_items(a, l, bid, nblk, tid);
            for (int item = bid; item < 512; item += nblk) { retb_stage(a, item, lds, tid, wave, lane); retb_compute(a, item, lds, tid, wave, lane); }
            for (int item = bid; item < 256; item += nblk) { ssdb_prep(a, l, item, lds, tid, wave, lane); ssdb_gt(lds, tid, wave, lane);
                for (int hh = 0; hh < 8; ++hh) ssdb_head(a, l, item, hh, lds, tid, wave, lane); } }
        else if (k == 5) { pg8::Gemm g{H, 1024, WinT + (size_t)N1A * 1024, T, N1B, 1024}; pg8::StaticOrder S; S.init(T, N1B, nblk, bid); EpiIn2 E{PA}; pg8::gemm_phase(lds, g, S, E, pg8::AMapLinear{}); }
        else if (k == 6) { pg8::Gemm g{PA, NA, WbrT, T, 1024, 2048}; pg8::StaticOrder S; S.init(T, 1024, nblk, bid); EpiMerge E{PA, (const float*)(a.ws + WS_SSQ), H}; pg8::gemm_phase(lds, g, S, E, pg8::AMapBranch{}); }
        else { pg8::Gemm g{H, 1024, WoutT, T, 1024, 1024}; pg8::StaticOrder S; S.init(T, 1024, nblk, bid);
            EpiOut E{xcur, a.out, (const float*)(a.ws + WS_ADA) + (size_t)l * 8 * 3072 + 2048}; pg8::gemm_phase(lds, g, S, E, pg8::AMapLinear{}); }
        if (!MK_SPLIT && ph + 1 < hi) xcd_barrier(bar);
    }
}

extern "C" void kernel_launch(void* const* d_in, const int* in_sizes, int n_in, void* d_out, int out_size, void* d_ws, size_t ws_size, hipStream_t stream) {
    static int grid = 0;
    if (grid == 0) {
        if (n_in != 19 || in_sizes[0] != T * D || out_size != T * D || ws_size < WS_END) { fprintf(stderr, "kernel_launch: unexpected shapes (n_in %d, in0 %d, out %d, ws %zu, need %zu)\n", n_in, n_in > 0 ? in_sizes[0] : -1, out_size, ws_size, (size_t)WS_END); grid = -1; return; }
        int dev = 0, cus = 0, per_cu = 0;
        if (hipGetDevice(&dev) != hipSuccess || hipDeviceGetAttribute(&cus, hipDeviceAttributeMultiprocessorCount, dev) != hipSuccess) { grid = -1; return; }
        if (hipFuncSetAttribute((const void*)mk_fwd, hipFuncAttributeMaxDynamicSharedMemorySize, LDS_BYTES) != hipSuccess) { fprintf(stderr, "kernel_launch: hipFuncSetAttribute failed\n"); grid = -1; return; }
        if (hipOccupancyMaxActiveBlocksPerMultiprocessor(&per_cu, (const void*)mk_fwd, 512, LDS_BYTES) != hipSuccess || per_cu < 1) { fprintf(stderr, "kernel_launch: occupancy query says %d blocks per CU\n", per_cu); }
        (void)hipGetLastError();
        grid = cus;
        if (grid != 256) fprintf(stderr, "kernel_launch: %d CUs (built for 256)\n", grid);
    }
    if (grid < 0) return;
    (void)hipMemsetAsync((char*)d_ws + WS_CTL, 0, CTL_BYTES, stream);
    KArgs a{};
    for (int i = 0; i < 19; ++i) a.in[i] = d_in[i];
    a.out = (float*)d_out; a.ws = (unsigned char*)d_ws;
#if MK_SPLIT
    for (int ph = 0; ph < NPHASE && ph < MK_PH_HI; ++ph) { a.ph_lo = ph; a.ph_hi = ph + 1; hipLaunchKernelGGL(mk_fwd, dim3(grid), dim3(512), LDS_BYTES, stream, a); }
#else
    a.ph_lo = 0; a.ph_hi = NPHASE;
    hipLaunchKernelGGL(mk_fwd, dim3(grid), dim3(512), LDS_BYTES, stream, a);
#endif
}
```

```cpp
#include <hip/hip_runtime.h>
#include <cstdio>
#include <cstdint>

#ifndef MK_SPLIT
#define MK_SPLIT 0
#endif
#ifndef MK_OFF
#define MK_OFF 0
#endif
#ifndef MK_SC1
#define MK_SC1 1
#endif
#ifndef MK_REP_PH
#define MK_REP_PH -1
#endif
#ifndef MK_REP_N
#define MK_REP_N 2
#endif
#ifndef MK_PH_HI
#define MK_PH_HI 1000
#endif

#define LAS __attribute__((address_space(3)))
#define GAS __attribute__((address_space(1)))
typedef unsigned short bf16_t;
typedef short bf16x8 __attribute__((ext_vector_type(8)));
typedef float f32x4 __attribute__((ext_vector_type(4)));
typedef float f32x2 __attribute__((ext_vector_type(2)));
typedef unsigned u32x4 __attribute__((ext_vector_type(4)));
typedef unsigned u32x2 __attribute__((ext_vector_type(2)));

constexpr int BATCH = 8, SEQ = 2048, D = 1024, T = BATCH * SEQ, DEPTH = 2;
constexpr int IN_W = 9744;
constexpr int C_RQ = 0, C_RK = 512, C_RV = 1024, C_RG = 1536, C_SZ = 2048, C_XBC = 3072, C_DT = 4608, C_CB = 4624, C_CC = 5136, C_CH = 5648, C_CG = 6160, C_MG = 6672;
constexpr int NA = 5632;
constexpr int PA_Q = 0, PA_K = 512, PA_V = 1024, PA_G = 1536, PA_Z = 2048, PA_XBC = 3072, PA_U = 4608, PA_W = 5120;
constexpr int N1A = 26 * 256, N1B = 12 * 256, NW1 = N1A + N1B;
constexpr float EPS = 1e-6f;

constexpr size_t WS_CTL = 0, CTL_BYTES = 1u << 20;
constexpr size_t WS_ADA = WS_CTL + CTL_BYTES;
constexpr size_t WS_CS = WS_ADA + (size_t)2 * 8 * 3072 * 4;
constexpr size_t WS_DT = WS_CS + (size_t)T * 64 * 2 * 4;
constexpr size_t WS_SSQ = WS_DT + (size_t)T * 16 * 4;
constexpr size_t WS_WIN = WS_SSQ + (size_t)T * 16 * 4;
constexpr size_t WS_WBR = WS_WIN + (size_t)NW1 * 1024 * 2;
constexpr size_t WS_WOUT = WS_WBR + (size_t)1024 * 2048 * 2;
constexpr size_t WS_H = WS_WOUT + (size_t)1024 * 1024 * 2;
constexpr size_t WS_PA = WS_H + (size_t)T * 1024 * 2;
constexpr size_t WS_RS = WS_PA + (size_t)T * NA * 2;
constexpr size_t WS_SS = WS_RS + (size_t)512 * 128 * 128 * 2;
constexpr size_t WS_CD = WS_SS + (size_t)2048 * 64 * 128 * 2;
constexpr size_t WS_WDT = WS_CD + (size_t)2048 * 4;
constexpr size_t WS_HB = WS_WDT + (size_t)2 * 16 * 1024 * 2;
constexpr size_t WS_END = WS_HB + (size_t)(T / 128) * 3 * 1536 * 2;
static_assert(WS_END <= 319291392ull, "workspace");

constexpr int CW_BAR = 4096;

constexpr int RING_BYTES = 131072;
constexpr int MISC_OFF = RING_BYTES + 320;
constexpr int LDS_BYTES = 147456;

#define LDS_WAIT() asm volatile("s_waitcnt lgkmcnt(0)" ::: "memory")
#define VM_WAIT() asm volatile("s_waitcnt vmcnt(0)" ::: "memory")
__device__ __forceinline__ unsigned f2bf(float f) { unsigned u = __builtin_bit_cast(unsigned, f); return (u + 0x7fffu + ((u >> 16) & 1u)) >> 16; }
__device__ __forceinline__ unsigned pk2(float lo, float hi) { return f2bf(lo) | (f2bf(hi) << 16); }
__device__ __forceinline__ float bf2f(unsigned short b) { return __builtin_bit_cast(float, ((unsigned)b) << 16); }
__device__ __forceinline__ float bflo(unsigned w) { return __builtin_bit_cast(float, w << 16); }
__device__ __forceinline__ float bfhi(unsigned w) { return __builtin_bit_cast(float, w & 0xffff0000u); }
__device__ __forceinline__ float bfe(const u32x4 v, int j) { const unsigned w = v[j >> 1]; return (j & 1) ? bfhi(w) : bflo(w); }
#define SWZ_XOR(v, m) __builtin_bit_cast(float, __builtin_amdgcn_ds_swizzle(__builtin_bit_cast(int, (v)), (((m) << 10) | 0x1f)))
__device__ __forceinline__ float wave_sum(float v) {
    v += SWZ_XOR(v, 1); v += SWZ_XOR(v, 2); v += SWZ_XOR(v, 4); v += SWZ_XOR(v, 8); v += SWZ_XOR(v, 16);
    return __builtin_bit_cast(float, __builtin_amdgcn_readlane(__builtin_bit_cast(int, v), 0)) + __builtin_bit_cast(float, __builtin_amdgcn_readlane(__builtin_bit_cast(int, v), 32));
}
__device__ __forceinline__ float silu_f(float x) { return x / (1.0f + __expf(-x)); }

#define XB_TMO      128
#define XB_XCNT(j)  (256  + 64 * (j))
#define XB_XSUB(j)  (1280 + 64 * (j))
#define XB_XGEN(j)  (2304 + 64 * (j))
#define XB_TOP      3328
#define XB_TOPGEN   3392
#define XCD_BAR_WORDS 3456
#define XB_SPIN_CAP (1u << 18)
__device__ __forceinline__ unsigned xb_ld(unsigned* p)              { return __hip_atomic_load(p, __ATOMIC_RELAXED, __HIP_MEMORY_SCOPE_AGENT); }
__device__ __forceinline__ unsigned xb_add(unsigned* p, unsigned v) { return __hip_atomic_fetch_add(p, v, __ATOMIC_RELAXED, __HIP_MEMORY_SCOPE_AGENT); }
__device__ __forceinline__ unsigned xb_xcc_id() { return (unsigned)__builtin_amdgcn_s_getreg((3 << 11) | 20) & 0xFu; }
#define XB_SPIN(cond, bar) do { unsigned _sp = 0; while (cond) { __builtin_amdgcn_s_sleep(1); \
    if ((++_sp & 255u) == 0u) { if (xb_ld(&(bar)[XB_TMO])) break; if (_sp > XB_SPIN_CAP) { atomicAdd(&(bar)[XB_TMO], 1u); break; } } } } while (0)
struct XcdBarrier { unsigned* bar; unsigned x; volatile LAS unsigned* st; };
__device__ __forceinline__ XcdBarrier xcd_barrier_post(unsigned* bar, volatile LAS unsigned* st) {
    XcdBarrier b; b.bar = bar; b.x = xb_xcc_id(); b.st = st;
    if (threadIdx.x == 0) (void)xb_add(&bar[XB_XCNT(b.x)], 1u);
    return b;
}
__device__ __forceinline__ void xcd_barrier_complete(unsigned* bar, unsigned x, unsigned& nloc, unsigned& nx) {
    const unsigned G = gridDim.x * gridDim.y * gridDim.z;
    unsigned sum, cnt, mine, sp = 0u;
    for (;;) {
        sum = 0u; cnt = 0u; mine = 0u;
#pragma unroll 1
        for (unsigned j = 0; j < 16; ++j) { const unsigned c = xb_ld(&bar[XB_XCNT(j)]); sum += c; cnt += (c > 0u) ? 1u : 0u; mine = (j == x) ? c : mine; }
        if (sum == G) break;
        __builtin_amdgcn_s_sleep(1);
        if ((++sp & 255u) == 0u) { if (xb_ld(&bar[XB_TMO])) break; if (sp > XB_SPIN_CAP) { atomicAdd(&bar[XB_TMO], 1u); break; } }
    }
    nloc = mine > 0u ? mine : 1u; nx = cnt > 0u ? cnt : 1u;
}
__device__ __forceinline__ void xcd_barrier(const XcdBarrier& b) {
    asm volatile("s_waitcnt vmcnt(0)" ::: "memory");
    __syncthreads();
    if (threadIdx.x == 0) {
        unsigned* bar = b.bar;
        __builtin_amdgcn_s_waitcnt(0);
        unsigned nloc = b.st[0], nx = b.st[1];
        if (nloc == 0u) { xcd_barrier_complete(bar, b.x, nloc, nx); b.st[0] = nloc; b.st[1] = nx; }
        const unsigned old = xb_add(&bar[XB_XSUB(b.x)], 1u);
        const unsigned gen = old / nloc;
        if (old + 1u == (gen + 1u) * nloc) {
            __builtin_amdgcn_fence(__ATOMIC_RELEASE, "agent");
            asm volatile("s_waitcnt vmcnt(0)" ::: "memory");
            const unsigned og = xb_add(&bar[XB_TOP], 1u);
            const unsigned tg = og / nx;
            if (og + 1u == (tg + 1u) * nx) xb_add(&bar[XB_TOPGEN], 1u);
            else XB_SPIN(xb_ld(&bar[XB_TOPGEN]) == tg, bar);
            __builtin_amdgcn_fence(__ATOMIC_ACQUIRE, "agent");
            xb_add(&bar[XB_XGEN(b.x)], 1u);
            asm volatile("s_waitcnt vmcnt(0)" ::: "memory");
        } else {
            XB_SPIN(xb_ld(&bar[XB_XGEN(b.x)]) == gen, bar);
            __builtin_amdgcn_fence(__ATOMIC_ACQUIRE, "agent");
            asm volatile("s_waitcnt vmcnt(0)" ::: "memory");
        }
    }
    __syncthreads();
}

namespace pg8 {
constexpr int BM = 256, BK = 64, HALF = 128, HTB = HALF * BK * 2, STAGE_BYTES = 8 * HTB, NXCD = 8, WGM = 8;
__host__ __device__ __forceinline__ int lds_byte(int r, int c) { const int st = (r >> 4) * 2 + (c >> 5), rr = r & 15, cc = c & 31, ob = rr * 64 + cc * 2; return st * 1024 + (ob ^ (((ob >> 9) & 1) << 5)); }
__host__ __device__ __forceinline__ void stage_rc(int b, int& R, int& C) { const int st = b / 1024, sb = b % 1024, swz = sb ^ (((sb >> 9) & 1) << 5); R = (st >> 1) * 16 + swz / 64; C = (st & 1) * 32 + (swz % 64) / 2; }
__host__ __device__ __forceinline__ int perm32(int rho) { const int n = rho >> 4, i = rho & 15; return 8 * (i >> 2) + 4 * n + (i & 3); }
struct Unit { int pm, pn; };
struct Gemm { const bf16_t* A; int lda; const bf16_t* Bt; int M, N, K; };
struct StaticOrder {
    int nM, nN, nwg, G, c;
    __device__ void init(int M, int N, int G_, int c_) { nM = M / BM; nN = N / BM; nwg = nM * nN; G = G_; c = c_; }
    __device__ bool next(int i, Unit& u) const {
        const long L = (long)i * G + c; if (L >= nwg) return false;
        int wgid = (int)L; { const int q = nwg / NXCD, r = nwg % NXCD, xcd = wgid % NXCD, off = wgid / NXCD; wgid = (xcd < r ? xcd * (q + 1) : r * (q + 1) + (xcd - r) * q) + off; }
        const int nig = WGM * nN, gid = wgid / nig, fm = gid * WGM, gsz = (nM - fm) < WGM ? (nM - fm) : WGM;
        u.pm = fm + ((wgid % nig) % gsz); u.pn = (wgid % nig) / gsz; return true;
    }
};
__device__ __forceinline__ unsigned cvt_pk_bf16(float lo, float hi) { unsigned r; asm volatile("v_cvt_pk_bf16_f32 %0, %1, %2" : "=v"(r) : "v"(lo), "v"(hi)); return r; }

struct AMapLinear { static constexpr int NSEG = 1; __device__ __forceinline__ int seg_end(int, int nt) const { return nt; } __device__ __forceinline__ size_t koff(int t) const { return (size_t)t * (BK * 2); } };
struct AMapBranch { static constexpr int NSEG = 3; __device__ __forceinline__ int seg_end(int sg, int) const { return sg == 0 ? 16 : (sg == 1 ? 24 : 32); } __device__ __forceinline__ size_t koff(int t) const { const int col = t < 16 ? PA_Z + 64 * t : (t < 24 ? PA_G + 64 * (t - 16) : PA_W + 64 * (t - 24)); return (size_t)col * 2; } };

template <class Epi, class AMap>
__device__ __forceinline__ void gemm_phase(LAS unsigned char* lds, const Gemm g, const StaticOrder& S, const Epi& E, const AMap AM) {
    int tid = threadIdx.x; asm volatile("" : "+v"(tid));
    const int wid = __builtin_amdgcn_readfirstlane(tid >> 6), lane = tid & 63, wr = wid >> 2, wc = wid & 3, fr = lane & 15, fq = lane >> 4;
    const int K = g.K, nt = K / BK;
    unsigned voffA[2], voffB[2];
#pragma unroll
    for (int i = 0; i < 2; ++i) { int R, C; stage_rc(tid * 16 + i * 8192, R, C); const int Rb = Epi::PERM ? ((R & ~31) + perm32(R & 31)) : R;
        voffA[i] = (unsigned)(R * g.lda + C) * 2u; voffB[i] = (unsigned)(Rb * K + C) * 2u; }
    const size_t kstep = (size_t)(BK * 2);
    const size_t hstepA = (size_t)HALF * g.lda * 2, hstepB = (size_t)HALF * K * 2;
    const size_t tstepA = 2 * hstepA, tstepB = 2 * hstepB;
    const unsigned ldsw = (unsigned)wid * 1024u;
    const int aoff = lds_byte(wr * 64 + fr, fq * 8), boff = lds_byte(wc * 32 + fr, fq * 8);
#define PG8_SA(b, h) (((b) * 2 + (h)) * HTB)
#define PG8_SB(b, h) ((4 + (b) * 2 + (h)) * HTB)
#define PG8_STAGE(bufoff, gbase, voff) do { _Pragma("unroll") for (int _i = 0; _i < 2; ++_i) \
        __builtin_amdgcn_global_load_lds((const unsigned*)((const char*)(gbase) + (voff)[_i]), (LAS unsigned*)(lds + (bufoff) + ldsw + _i * 8192), 16, 0, 0); } while (0)
#define PG8_LDA(dst, b, h) do { _Pragma("unroll") for (int m = 0; m < 4; ++m) _Pragma("unroll") for (int k = 0; k < 2; ++k) dst[m][k] = *(const LAS bf16x8*)(lds + PG8_SA(b, h) + aoff + m * 2048 + k * 1024); } while (0)
#define PG8_LDB(dst, b, h) do { _Pragma("unroll") for (int n = 0; n < 2; ++n) _Pragma("unroll") for (int k = 0; k < 2; ++k) dst[n][k] = *(const LAS bf16x8*)(lds + PG8_SB(b, h) + boff + n * 2048 + k * 1024); } while (0)
#define PG8_MMA(ai, bj, At, Bt) do { __builtin_amdgcn_s_setprio(1); _Pragma("unroll") for (int m = 0; m < 4; ++m) _Pragma("unroll") for (int n = 0; n < 2; ++n) _Pragma("unroll") for (int k = 0; k < 2; ++k) \
        acc[ai][bj][m][n] = __builtin_amdgcn_mfma_f32_16x16x32_bf16(Bt[n][k], At[m][k], acc[ai][bj][m][n], 0, 0, 0); __builtin_amdgcn_s_setprio(0); } while (0)
#define PG8_WAIT_V(n) asm volatile("s_waitcnt vmcnt(" #n ")" ::: "memory")
#define PG8_WAIT_L(n) asm volatile("s_waitcnt lgkmcnt(" #n ")" ::: "memory")
#define PG8_BAR __builtin_amdgcn_s_barrier()
#define PG8_SCHED __builtin_amdgcn_sched_barrier(0)
    Unit cur, nxt; int ui = 0;
    if (!S.next(0, cur)) return;
    f32x4 acc[2][2][4][2];
#pragma unroll
    for (int a = 0; a < 2; ++a)
#pragma unroll
        for (int b = 0; b < 2; ++b)
#pragma unroll
            for (int m = 0; m < 4; ++m)
#pragma unroll
                for (int n = 0; n < 2; ++n) acc[a][b][m][n] = (f32x4){0.f, 0.f, 0.f, 0.f};
    bf16x8 At[4][2], B0[2][2], B1[2][2];
    const char* cAb = (const char*)g.A + (size_t)cur.pm * tstepA;
    const char* cB = (const char*)g.Bt + (size_t)cur.pn * tstepB;
    {
        const char* cA = cAb + AM.koff(0);
        PG8_STAGE(PG8_SB(0, 0), cB, voffB); PG8_STAGE(PG8_SA(0, 0), cA, voffA); PG8_STAGE(PG8_SB(0, 1), cB + hstepB, voffB); PG8_STAGE(PG8_SA(0, 1), cA + hstepA, voffA);
        if (wr == 1) PG8_BAR;
        PG8_WAIT_V(4); PG8_BAR;
        PG8_STAGE(PG8_SB(1, 0), cB + kstep, voffB); PG8_STAGE(PG8_SA(1, 0), cA + kstep, voffA); PG8_STAGE(PG8_SB(1, 1), cB + hstepB + kstep, voffB);
        PG8_WAIT_V(6); PG8_BAR;
    }
    for (;;) {
        const bool has_next = S.next(ui + 1, nxt);
        const char* nAb = has_next ? (const char*)g.A + (size_t)nxt.pm * tstepA : cAb; const char* nB = has_next ? (const char*)g.Bt + (size_t)nxt.pn * tstepB : cB;
        int t = 0;
#pragma unroll 1
        for (int sg = 0; sg < AMap::NSEG; ++sg) {
        const int te = AM.seg_end(sg, nt);
#pragma unroll 1
        for (; t < te; t += 2) {
            const bool last = (t == nt - 2);
            const char* a1 = cAb + AM.koff(t + 1);
            const char* a2 = last ? nAb + AM.koff(0) : cAb + AM.koff(t + 2); const char* b2 = last ? nB : cB + (size_t)(t + 2) * kstep;
            const char* a3 = a2 + kstep; const char* b3 = b2 + kstep;
            PG8_LDB(B0, 0, 0); PG8_SCHED; PG8_LDA(At, 0, 0); PG8_STAGE(PG8_SA(1, 1), a1 + hstepA, voffA);
            PG8_WAIT_L(8); PG8_BAR; PG8_WAIT_L(0); PG8_MMA(0, 0, At, B0); PG8_BAR; PG8_SCHED;
            PG8_LDB(B1, 0, 1); PG8_STAGE(PG8_SB(0, 0), b2, voffB);
            PG8_BAR; PG8_WAIT_L(0); PG8_MMA(0, 1, At, B1); PG8_BAR;
            PG8_LDA(At, 0, 1); PG8_STAGE(PG8_SA(0, 0), a2, voffA);
            PG8_BAR; PG8_WAIT_L(0); PG8_MMA(1, 0, At, B0); PG8_BAR; PG8_SCHED;
            PG8_STAGE(PG8_SB(0, 1), b2 + hstepB, voffB);
            PG8_WAIT_V(6); PG8_BAR; PG8_MMA(1, 1, At, B1); PG8_BAR;
            PG8_LDB(B0, 1, 0); PG8_SCHED; PG8_LDA(At, 1, 0); PG8_STAGE(PG8_SA(0, 1), a2 + hstepA, voffA);
            PG8_WAIT_L(8); PG8_BAR; PG8_WAIT_L(0); PG8_MMA(0, 0, At, B0); PG8_BAR; PG8_SCHED;
            PG8_LDB(B1, 1, 1); PG8_STAGE(PG8_SB(1, 0), b3, voffB);
            PG8_BAR; PG8_WAIT_L(0); PG8_MMA(0, 1, At, B1); PG8_BAR;
            PG8_LDA(At, 1, 1); PG8_STAGE(PG8_SA(1, 0), a3, voffA);
            PG8_BAR; PG8_WAIT_L(0); PG8_MMA(1, 0, At, B0); PG8_BAR; PG8_SCHED;
            PG8_STAGE(PG8_SB(1, 1), b3 + hstepB, voffB);
            PG8_WAIT_V(6); PG8_BAR; PG8_MMA(1, 1, At, B1); PG8_BAR;
        }
        if (AMap::NSEG > 1 && sg + 1 < AMap::NSEG) E.mid(acc, cur, sg, wr, wc, fr, fq);
        }
        E(acc, cur, wr, wc, fr, fq);
        if (!has_next) break;
#pragma unroll
        for (int a = 0; a < 2; ++a)
#pragma unroll
            for (int b = 0; b < 2; ++b)
#pragma unroll
                for (int m = 0; m < 4; ++m)
#pragma unroll
                    for (int n = 0; n < 2; ++n) acc[a][b][m][n] = (f32x4){0.f, 0.f, 0.f, 0.f};
        cur = nxt; cAb = nAb; cB = nB; ++ui;
    }
    PG8_WAIT_V(0);
    if (wr == 0) PG8_BAR;
    PG8_BAR;
#undef PG8_SA
#undef PG8_SB
#undef PG8_STAGE
#undef PG8_LDA
#undef PG8_LDB
#undef PG8_MMA
#undef PG8_WAIT_V
#undef PG8_WAIT_L
#undef PG8_BAR
#undef PG8_SCHED
}
}
using pg8::cvt_pk_bf16;

struct EpiIn1 {
    static constexpr bool PERM = true;
    bf16_t* PA; bf16_t* HB;
    __device__ __forceinline__ void mid(f32x4 (&)[2][2][4][2], const pg8::Unit&, int, int, int, int, int) const {}
    __device__ __forceinline__ void operator()(const f32x4 (&acc)[2][2][4][2], const pg8::Unit& u, int wr, int wc, int fr, int fq) const {
        int row0 = u.pm * 256 + wr * 64 + fr; asm volatile("" : "+v"(row0));
        if (u.pn < 18) {
            const int col0 = u.pn * 256 + wc * 32 + 8 * fq;
#if MK_SC1
            const __amdgpu_buffer_rsrc_t rsrc = __builtin_amdgcn_make_buffer_rsrc((void*)PA, (short)0, (int)((size_t)T * NA * 2), 0x00020000);
#endif
#pragma unroll
            for (int ai = 0; ai < 2; ++ai)
#pragma unroll
                for (int m = 0; m < 4; ++m) { bf16_t* rowp = PA + (size_t)(row0 + ai * 128 + m * 16) * NA + col0;
#pragma unroll
                    for (int bj = 0; bj < 2; ++bj) { const f32x4 v0 = acc[ai][bj][m][0], v1 = acc[ai][bj][m][1];
                        u32x4 w; w.x = cvt_pk_bf16(v0[0], v0[1]); w.y = cvt_pk_bf16(v0[2], v0[3]); w.z = cvt_pk_bf16(v1[0], v1[1]); w.w = cvt_pk_bf16(v1[2], v1[3]);
#if MK_SC1
                        __builtin_amdgcn_raw_buffer_store_b128(w, rsrc, (int)(((size_t)(row0 + ai * 128 + m * 16) * NA + col0 + bj * 128) * 2), 0, 16);
#else
                        *(u32x4*)(rowp + bj * 128) = w;
#endif
                        if (m == 3 && u.pn >= 12 && wr == 1 && fr >= 13) {
                            const int row = row0 + ai * 128 + 48; *(u32x4*)(HB + ((size_t)(row >> 7) * 3 + (fr - 13)) * 1536 + (col0 - PA_XBC) + bj * 128) = w; } } }
        } else {
            const int ch0 = 64 * (u.pn - 18) + 16 * wc + 4 * fq;
#pragma unroll
            for (int ai = 0; ai < 2; ++ai)
#pragma unroll
                for (int m = 0; m < 4; ++m) { bf16_t* rowp = PA + (size_t)(row0 + ai * 128 + m * 16) * NA;
                    const f32x4 bg = acc[ai][0][m][0], cg = acc[ai][0][m][1], hv = acc[ai][1][m][0], gt = acc[ai][1][m][1];
                    f32x4 uu = cg * hv, ww;
#pragma unroll
                    for (int j = 0; j < 4; ++j) ww[j] = bg[j] * silu_f(gt[j]);
                    u32x2 pu, pw; pu.x = cvt_pk_bf16(uu[0], uu[1]); pu.y = cvt_pk_bf16(uu[2], uu[3]); pw.x = cvt_pk_bf16(ww[0], ww[1]); pw.y = cvt_pk_bf16(ww[2], ww[3]);
                    *(u32x2*)(rowp + PA_U + ch0) = pu; *(u32x2*)(rowp + PA_W + ch0) = pw; }
        }
    }
};
__device__ __forceinline__ int lg_col(int gate, int c) {
    return gate == 0 ? c : (gate == 1 ? PA_XBC + c : (c < 512 ? PA_V + c : PA_XBC + 1024 + (c - 512)));
}
struct EpiIn2 {
    static constexpr bool PERM = true;
    bf16_t* PA; const float* SSQ;
    __device__ __forceinline__ void mid(f32x4 (&)[2][2][4][2], const pg8::Unit&, int, int, int, int, int) const {}
    __device__ __forceinline__ void operator()(const f32x4 (&acc)[2][2][4][2], const pg8::Unit& u, int wr, int wc, int fr, int fq) const {
        int row0 = u.pm * 256 + wr * 64 + fr; asm volatile("" : "+v"(row0));
        const int gate = u.pn >> 2, cbase = (u.pn & 3) * 256;
#pragma unroll
        for (int ai = 0; ai < 2; ++ai)
#pragma unroll
            for (int m = 0; m < 4; ++m) { const int row = row0 + ai * 128 + m * 16; bf16_t* rowp = PA + (size_t)row * NA;
                float rinv = 1.0f;
                if (gate == 1) { const f32x2 q = *(const f32x2*)(SSQ + (size_t)row * 2); rinv = sqrtf((q[0] + q[1]) * (1.0f / 1024.0f) + EPS); }
#pragma unroll
                for (int bj = 0; bj < 2; ++bj) { f32x4 v0 = acc[ai][bj][m][0], v1 = acc[ai][bj][m][1];
#pragma unroll
                    for (int j = 0; j < 4; ++j) { v0[j] = (1.0f + __expf(-fminf(fmaxf(v0[j], -30.f), 30.f))) * rinv; v1[j] = (1.0f + __expf(-fminf(fmaxf(v1[j], -30.f), 30.f))) * rinv; }
                    u32x4 w; w.x = cvt_pk_bf16(v0[0], v0[1]); w.y = cvt_pk_bf16(v0[2], v0[3]); w.z = cvt_pk_bf16(v1[0], v1[1]); w.w = cvt_pk_bf16(v1[2], v1[3]);
                    const int c = cbase + bj * 128 + wc * 32 + 8 * fq;
                    *(u32x4*)(rowp + lg_col(gate, c)) = w; } }
    }
};
struct EpiMerge {
    static constexpr bool PERM = true;
    const bf16_t* PA; bf16_t* MG;
    __device__ __forceinline__ void scale8(f32x4& v0, f32x4& v1, const u32x4 nn, const u32x4 dn) const {
#pragma unroll
        for (int j = 0; j < 4; ++j) { v0[j] *= bfe(nn, j) * __builtin_amdgcn_rcpf(bfe(dn, j)); v1[j] *= bfe(nn, 4 + j) * __builtin_amdgcn_rcpf(bfe(dn, 4 + j)); }
    }
    __device__ __forceinline__ void mid(f32x4 (&acc)[2][2][4][2], const pg8::Unit& u, int sg, int wr, int wc, int fr, int fq) const {
        int row0 = u.pm * 256 + wr * 64 + fr; asm volatile("" : "+v"(row0));
        const int c0 = u.pn * 256 + wc * 32 + 8 * fq;
        const int ncol = sg == 0 ? lg_col(0, c0) : lg_col(2, c0), dcol = sg == 0 ? lg_col(1, c0) : lg_col(0, c0);
#pragma unroll
        for (int ai = 0; ai < 2; ++ai) {
            u32x4 nn[4][2], dn[4][2];
#pragma unroll
            for (int m = 0; m < 4; ++m) { const bf16_t* rowp = PA + (size_t)(row0 + ai * 128 + m * 16) * NA;
#pragma unroll
                for (int bj = 0; bj < 2; ++bj) { nn[m][bj] = *(const u32x4*)(rowp + ncol + bj * 128); dn[m][bj] = *(const u32x4*)(rowp + dcol + bj * 128); } }
#pragma unroll
            for (int m = 0; m < 4; ++m)
#pragma unroll
                for (int bj = 0; bj < 2; ++bj) scale8(acc[ai][bj][m][0], acc[ai][bj][m][1], nn[m][bj], dn[m][bj]);
            asm volatile("" ::: "memory"); }
    }
    __device__ __forceinline__ void operator()(const f32x4 (&acc)[2][2][4][2], const pg8::Unit& u, int wr, int wc, int fr, int fq) const {
        int row0 = u.pm * 256 + wr * 64 + fr; asm volatile("" : "+v"(row0));
        const int c0 = u.pn * 256 + wc * 32 + 8 * fq, dcol = lg_col(2, c0);
#pragma unroll
        for (int ai = 0; ai < 2; ++ai) {
            u32x4 dn[4][2];
#pragma unroll
            for (int m = 0; m < 4; ++m)
#pragma unroll
                for (int bj = 0; bj < 2; ++bj) dn[m][bj] = *(const u32x4*)(PA + (size_t)(row0 + ai * 128 + m * 16) * NA + dcol + bj * 128);
#pragma unroll
            for (int m = 0; m < 4; ++m)
#pragma unroll
                for (int bj = 0; bj < 2; ++bj) { f32x4 v0 = acc[ai][bj][m][0], v1 = acc[ai][bj][m][1];
#pragma unroll
                    for (int j = 0; j < 4; ++j) { v0[j] *= __builtin_amdgcn_rcpf(bfe(dn[m][bj], j)); v1[j] *= __builtin_amdgcn_rcpf(bfe(dn[m][bj], 4 + j)); }
                    u32x4 w; w.x = cvt_pk_bf16(v0[0], v0[1]); w.y = cvt_pk_bf16(v0[2], v0[3]); w.z = cvt_pk_bf16(v1[0], v1[1]); w.w = cvt_pk_bf16(v1[2], v1[3]);
                    *(u32x4*)(MG + (size_t)(row0 + ai * 128 + m * 16) * 1024 + c0 + bj * 128) = w; }
            asm volatile("" ::: "memory"); }
    }
};
struct EpiOut {
    static constexpr bool PERM = false;
    const float* xin; float* xout; const float* rgate;
    __device__ __forceinline__ void mid(f32x4 (&)[2][2][4][2], const pg8::Unit&, int, int, int, int, int) const {}
    __device__ __forceinline__ void operator()(const f32x4 (&acc)[2][2][4][2], const pg8::Unit& u, int wr, int wc, int fr, int fq) const {
        int row0 = u.pm * 256 + wr * 64 + fr, col0 = u.pn * 256 + wc * 32 + 4 * fq; asm volatile("" : "+v"(row0), "+v"(col0));
        const float* rg = rgate + (size_t)(u.pm / 8) * 3072 + col0;
        f32x4 gv[2][2];
#pragma unroll
        for (int bj = 0; bj < 2; ++bj)
#pragma unroll
            for (int n = 0; n < 2; ++n) gv[bj][n] = *(const f32x4*)(rg + bj * 128 + n * 16);
#pragma unroll
        for (int ai = 0; ai < 2; ++ai)
#pragma unroll
            for (int m = 0; m < 4; ++m) { const size_t off = (size_t)(row0 + ai * 128 + m * 16) * D + col0;
#pragma unroll
                for (int bj = 0; bj < 2; ++bj)
#pragma unroll
                    for (int n = 0; n < 2; ++n) { const f32x4 xv = *(const f32x4*)(xin + off + bj * 128 + n * 16);
                        *(f32x4*)(xout + off + bj * 128 + n * 16) = xv + gv[bj][n] * acc[ai][bj][m][n]; }
                asm volatile("" ::: "memory"); }
    }
};

struct KArgs { const void* in[19]; float* out; unsigned char* ws; int ph_lo, ph_hi; };
constexpr int ARGS_OFF = RING_BYTES + 512;
enum { I_X = 0, I_C, I_POS, I_NORM_G, I_W_ADA, I_B_ADA, I_W_IN, I_CONV_W, I_CONV_B, I_DT_BIAS, I_A_LOG, I_SSM_D, I_SSM_NORM_G, I_SC_CONV_W, I_W_BR_RET, I_W_BR_SSM, I_W_BR_SC, I_W_OUT, I_FINAL_G };
struct Args { LAS unsigned char* lds; float* out; unsigned char* ws;
    __device__ __forceinline__ const float* f(int i) const { const LAS unsigned* p = (const LAS unsigned*)(lds + ARGS_OFF) + 2 * i;
        const unsigned lo = __builtin_amdgcn_readfirstlane(p[0]), hi = __builtin_amdgcn_readfirstlane(p[1]); return (const float*)(((unsigned long long)hi << 32) | lo); }
};
#define ARGF(name, idx) const float* const name = a.f(idx)

__device__ __forceinline__ int win_srccol(int n) {
    if (n < 4608) return n;
    if (n < N1A) { const int p = (n - 4608) & 255, tt = (n - 4608) >> 8; const int bj = p >> 7, wc = (p >> 5) & 3, fq = (p >> 3) & 3, nn = (p >> 2) & 1, e = p & 3;
        const int q = 2 * bj + nn, ch = 64 * tt + 16 * wc + 4 * fq + e; return C_CB + 512 * q + ch; }
    return C_MG + (n - N1A);
}
struct WItem { const float* src; const float* scale; bf16_t* dst; int ldsrc, k0, nsrc, ldd, dk0, n0; };
__device__ __forceinline__ WItem witem(const Args a, int l, int it, int lane) {
    constexpr int I_IN = (NW1 / 32) * 16, I_BR = 32 * 32;
    WItem w; w.scale = nullptr;
    bf16_t* WinT = (bf16_t*)(a.ws + WS_WIN); bf16_t* WbrT = (bf16_t*)(a.ws + WS_WBR); bf16_t* WoutT = (bf16_t*)(a.ws + WS_WOUT);
    if (it < I_IN) { const int nb = it / 16, kb = it % 16; w.src = a.f(I_W_IN) + (size_t)l * 1024 * IN_W; w.ldsrc = IN_W; w.k0 = 64 * kb; w.nsrc = win_srccol(32 * nb + (lane & 31)); w.dst = WinT; w.ldd = 1024; w.dk0 = 64 * kb; w.n0 = 32 * nb; return w; }
    it -= I_IN;
    if (it < I_BR) { const int nb = it / 32, kb = it % 32; w.ldsrc = 1024; w.nsrc = 32 * nb + (lane & 31); w.dst = WbrT; w.ldd = 2048; w.dk0 = 64 * kb; w.n0 = 32 * nb;
        if (kb < 16) { w.src = a.f(I_W_BR_SSM) + (size_t)l * 1024 * 1024; w.k0 = 64 * kb; w.scale = a.f(I_SSM_NORM_G) + l * 1024; }
        else if (kb < 24) { w.src = a.f(I_W_BR_RET) + (size_t)l * 512 * 1024; w.k0 = 64 * (kb - 16); }
        else { w.src = a.f(I_W_BR_SC) + (size_t)l * 512 * 1024; w.k0 = 64 * (kb - 24); }
        return w; }
    it -= I_BR;
    { const int nb = it / 16, kb = it % 16; w.src = a.f(I_W_OUT) + (size_t)l * 1024 * 1024; w.ldsrc = 1024; w.k0 = 64 * kb; w.nsrc = 32 * nb + (lane & 31); w.dst = WoutT; w.ldd = 1024; w.dk0 = 64 * kb; w.n0 = 32 * nb; }
    return w;
}
__device__ __forceinline__ void wload(const WItem& w, int lane, float (&v)[32]) {
#pragma unroll
    for (int i = 0; i < 32; ++i) { const int kk = 2 * i + (lane >> 5); float x = w.nsrc < 0 ? 0.f : w.src[(size_t)(w.k0 + kk) * w.ldsrc + w.nsrc]; if (w.scale) x *= w.scale[w.k0 + kk]; v[i] = x; }
}
__device__ __forceinline__ void wstore(const WItem& w, int lane, const float (&v)[32], LAS float* scr) {
#pragma unroll
    for (int i = 0; i < 32; ++i) scr[(2 * i + (lane >> 5)) * 33 + (lane & 31)] = v[i];
    LDS_WAIT(); asm volatile("" ::: "memory");
    const int c = lane & 7;
#pragma unroll
    for (int j = 0; j < 4; ++j) { const int n = (lane >> 3) + 8 * j; const LAS float* s = scr + (8 * c) * 33 + n;
        u32x4 o; o.x = pk2(s[0 * 33], s[1 * 33]); o.y = pk2(s[2 * 33], s[3 * 33]); o.z = pk2(s[4 * 33], s[5 * 33]); o.w = pk2(s[6 * 33], s[7 * 33]);
        *(u32x4*)(w.dst + (size_t)(w.n0 + n) * w.ldd + w.dk0 + 8 * c) = o; }
    LDS_WAIT(); asm volatile("" ::: "memory");
}
__device__ __attribute__((noinline)) void convert_weights(const Args a, int l, LAS unsigned char* lds, int gw, int NGW, int wave, int lane) {
    l = __builtin_amdgcn_readfirstlane(l); gw = __builtin_amdgcn_readfirstlane(gw); NGW = __builtin_amdgcn_readfirstlane(NGW); wave = __builtin_amdgcn_readfirstlane(wave);
    LAS float* scr = (LAS float*)(lds + wave * 16384);
    constexpr int NIT = (NW1 / 32) * 16 + 32 * 32 + 32 * 16;
    if (gw >= NIT) return;
    float v[32]; WItem cur = witem(a, l, gw, lane); wload(cur, lane, v);
#pragma unroll 1
    for (int it = gw; it < NIT; it += NGW) {
        const bool more = it + NGW < NIT;
        float nv[32]; WItem nxt = cur;
        if (more) { nxt = witem(a, l, it + NGW, lane); wload(nxt, lane, nv); }
        wstore(cur, lane, v, scr);
        if (more) { cur = nxt;
#pragma unroll
            for (int i = 0; i < 32; ++i) v[i] = nv[i]; }
    }
}

__device__ __attribute__((noinline)) void phase_p0(const Args a, LAS unsigned char* lds, int bid, int nblk, int tid, int wave, int lane) {
    float* ada = (float*)(a.ws + WS_ADA);
    LAS float* scs = (LAS float*)lds;
    LAS float* red = (LAS float*)(lds + 32768);
    for (int i = tid; i < 8 * 1024; i += 512) scs[i] = silu_f(a.f(I_C)[i]);
    __syncthreads();
    for (int item = bid; item < 256; item += nblk) {
        const int l = item >> 7, j0 = 24 * (item & 127);
        if (tid < 504) { const int jl = tid % 24, kg = tid / 24; float acc[8];
#pragma unroll
            for (int b = 0; b < 8; ++b) acc[b] = 0.f;
            const float* w = a.f(I_W_ADA) + (size_t)l * 1024 * 3072 + j0 + jl;
            for (int k = kg; k < 1024; k += 21) { const float wv = w[(size_t)k * 3072];
#pragma unroll
                for (int b = 0; b < 8; ++b) acc[b] += scs[b * 1024 + k] * wv; }
#pragma unroll
            for (int b = 0; b < 8; ++b) red[(kg * 24 + jl) * 8 + b] = acc[b]; }
        __syncthreads();
        if (tid < 192) { const int jl = tid >> 3, b = tid & 7; float s = 0.f;
            for (int kg = 0; kg < 21; ++kg) s += red[(kg * 24 + jl) * 8 + b];
            ada[((size_t)l * 8 + b) * 3072 + j0 + jl] = s + a.f(I_B_ADA)[l * 3072 + j0 + jl]; }
        __syncthreads();
    }
    float* cs = (float*)(a.ws + WS_CS);
    for (int idx = bid * 512 + tid; idx < T * 64; idx += nblk * 512) { const int t = idx >> 6, i = idx & 63;
        const float inv_freq = powf(10000.0f, -(float)(2 * i) / 128.0f); const float ang = (float)((const int*)a.f(I_POS))[t] * inv_freq;
        cs[2 * (size_t)idx] = cosf(ang); cs[2 * (size_t)idx + 1] = sinf(ang); }
    { bf16_t* WdtT = (bf16_t*)(a.ws + WS_WDT); const float* w_in = a.f(I_W_IN);
      for (int idx = bid * 512 + tid; idx < 2 * 16 * 1024; idx += nblk * 512) { const int ll = idx >> 14, j = (idx >> 10) & 15, k = idx & 1023;
          WdtT[idx] = (bf16_t)f2bf(w_in[((size_t)ll * 1024 + k) * IN_W + C_DT + j]); } }
}

__device__ __attribute__((noinline)) void phase_hprep(const Args a, int l, const float* xcur, LAS unsigned char* lds, int bid, int nblk, int tid, int wave, int lane) {
    const float* ada = (const float*)(a.ws + WS_ADA) + (size_t)l * 8 * 3072;
    bf16_t* H = (bf16_t*)(a.ws + WS_H);
    const float* ng = a.f(I_NORM_G) + l * 1024;
    const int gw = bid * 8 + wave, NGW = nblk * 8;
    const bf16_t* WdtT = (const bf16_t*)(a.ws + WS_WDT) + (size_t)l * 16 * 1024; float* DT = (float*)(a.ws + WS_DT);
    const int fr = lane & 15, fq = lane >> 4;
    const float dtb = a.f(I_DT_BIAS)[l * 16 + fr];
    for (int base = gw * 8; base < T; base += NGW * 8) {
#pragma unroll
        for (int hf = 0; hf < 2; ++hf) {
            f32x4 v[4][4];
#pragma unroll
            for (int u = 0; u < 4; ++u) { const f32x4* xr = (const f32x4*)(xcur + (size_t)(base + 4 * hf + u) * D) + lane;
#pragma unroll
                for (int j = 0; j < 4; ++j) v[u][j] = xr[64 * j]; }
#pragma unroll
            for (int u = 0; u < 4; ++u) { const int tok = base + 4 * hf + u; const int b = tok >> 11; float s = 0.f;
#pragma unroll
                for (int j = 0; j < 4; ++j) s += (v[u][j][0] * v[u][j][0] + v[u][j][1] * v[u][j][1]) + (v[u][j][2] * v[u][j][2] + v[u][j][3] * v[u][j][3]);
                const float rstd = 1.0f / sqrtf(wave_sum(s) * (1.0f / D) + EPS);
                const float* shift = ada + (size_t)b * 3072; const float* scale = shift + 1024;
                unsigned long long* o8 = (unsigned long long*)(H + (size_t)tok * D) + lane;
#pragma unroll
                for (int j = 0; j < 4; ++j) { const int c = 4 * lane + 256 * j;
                    const f32x4 g = *(const f32x4*)(ng + c), sc = *(const f32x4*)(scale + c), sh = *(const f32x4*)(shift + c);
                    const f32x4 hv = (v[u][j] * rstd) * g * (sc + 1.0f) + sh;
                    o8[64 * j] = (unsigned long long)pk2(hv[0], hv[1]) | ((unsigned long long)pk2(hv[2], hv[3]) << 32); } }
        }
        VM_WAIT();
        { f32x4 acc = (f32x4){0.f, 0.f, 0.f, 0.f};
          const bf16_t* hp = H + (size_t)(base + (fr & 7)) * D + 8 * fq; const bf16_t* wp = WdtT + fr * 1024 + 8 * fq;
#pragma unroll 8
          for (int ks = 0; ks < 32; ++ks) acc = __builtin_amdgcn_mfma_f32_16x16x32_bf16(__builtin_bit_cast(bf16x8, *(const u32x4*)(hp + 32 * ks)), __builtin_bit_cast(bf16x8, *(const u32x4*)(wp + 32 * ks)), acc, 0, 0, 0);
          if (fq < 2) {
#pragma unroll
              for (int r = 0; r < 4; ++r) { const float xv = acc[r] + dtb; DT[(size_t)(base + 4 * fq + r) * 16 + fr] = xv > 20.f ? xv : log1pf(__expf(xv)); } } }
    }
}

__device__ __attribute__((noinline)) void sc_items(const Args a, int l, int vb, int nvb, int tid, int dry) {
    bf16_t* PA = (bf16_t*)(a.ws + WS_PA); const float* cw = a.f(I_SC_CONV_W) + (size_t)l * 3 * 512;
    for (int idx0 = vb * 512 + tid; idx0 < T * 64; idx0 += 4 * nvb * 512) {
        u32x4 u2[4], u1[4], u0[4], wv[4];
#pragma unroll
        for (int q = 0; q < 4; ++q) { const int idx = idx0 + q * nvb * 512 < T * 64 ? idx0 + q * nvb * 512 : idx0; const int row = idx >> 6, c0 = (idx & 63) * 8, tl = row & (SEQ - 1);
            const bf16_t* rp = PA + (size_t)row * NA;
            u2[q] = *(const u32x4*)(rp + PA_U + c0); u1[q] = (u32x4){0u, 0u, 0u, 0u}; u0[q] = u1[q];
            if (tl >= 1) u1[q] = *(const u32x4*)(rp - NA + PA_U + c0);
            if (tl >= 2) u0[q] = *(const u32x4*)(rp - 2 * NA + PA_U + c0);
            wv[q] = *(const u32x4*)(rp + PA_W + c0); }
#pragma unroll
        for (int q = 0; q < 4; ++q) { const int idx = idx0 + q * nvb * 512; if (idx >= T * 64) break; const int row = idx >> 6, c0 = (idx & 63) * 8;
            float o[8];
#pragma unroll
            for (int j = 0; j < 4; ++j) { const int ca = c0 + 2 * j, cbb = ca + 1;
                o[2 * j] = bflo(wv[q][j]) * (cw[ca] * bflo(u0[q][j]) + cw[512 + ca] * bflo(u1[q][j]) + cw[1024 + ca] * bflo(u2[q][j]));
                o[2 * j + 1] = bfhi(wv[q][j]) * (cw[cbb] * bfhi(u0[q][j]) + cw[512 + cbb] * bfhi(u1[q][j]) + cw[1024 + cbb] * bfhi(u2[q][j])); }
            u32x4 r; r.x = pk2(o[0], o[1]); r.y = pk2(o[2], o[3]); r.z = pk2(o[4], o[5]); r.w = pk2(o[6], o[7]);
            if (!dry) *(u32x4*)(PA + (size_t)row * NA + PA_W + c0) = r; }
    }
}
typedef short bf16x4 __attribute__((ext_vector_type(4)));
constexpr int LDP = 136;
__device__ __forceinline__ f32x4 mfma16(bf16x8 a, bf16x8 b, f32x4 c) { return __builtin_amdgcn_mfma_f32_16x16x32_bf16(a, b, c, 0, 0, 0); }
__device__ __forceinline__ bf16x8 as_frag(u32x4 v) { return __builtin_bit_cast(bf16x8, v); }
__device__ __forceinline__ float xor16(float v) { return SWZ_XOR(v, 16); }
__device__ __forceinline__ float xor32(float v, int lane) { return __builtin_bit_cast(float, __builtin_amdgcn_ds_bpermute((lane ^ 32) << 2, __builtin_bit_cast(int, v))); }

typedef short s16x4 __attribute__((ext_vector_type(4)));
__device__ __forceinline__ bf16x8 frag_tr2(const LAS bf16_t* base, int pitch, int R, int R2, int C, int lane) {
    const int i = lane & 15, off = (i >> 2) * pitch + C + 4 * (i & 3);
    const s16x4 lo = __builtin_amdgcn_ds_read_tr16_b64_v4i16((LAS s16x4*)(base + R * pitch + off));
    const s16x4 hi = __builtin_amdgcn_ds_read_tr16_b64_v4i16((LAS s16x4*)(base + R2 * pitch + off));
    return (bf16x8){lo[0], lo[1], lo[2], lo[3], hi[0], hi[1], hi[2], hi[3]};
}
__device__ __forceinline__ void ret_stage_vn(const bf16_t* PA, size_t row0, int h, LAS bf16_t* Vn, int tid) {
#pragma unroll
    for (int r = 0; r < 4; ++r) { const int idx = tid + 512 * r, tok = idx >> 4, c = idx & 15;
        *(LAS u32x4*)(Vn + tok * LDP + 8 * c) = *(const u32x4*)(PA + (row0 + tok) * NA + PA_V + 128 * h + 8 * c); }
}
__device__ __forceinline__ void ret_stage_vt(const bf16_t* PA, size_t row0, int h, LAS bf16_t* Vt, int wave, int lane) {
    const size_t rowA = row0 + 2 * lane;
#pragma unroll
    for (int r = 0; r < 2; ++r) { const int c0 = 8 * (wave + 8 * r);
        const u32x4 va = *(const u32x4*)(PA + rowA * NA + PA_V + 128 * h + c0), vb = *(const u32x4*)(PA + (rowA + 1) * NA + PA_V + 128 * h + c0);
#pragma unroll
        for (int j = 0; j < 8; ++j) { const unsigned a = (va[j >> 1] >> (16 * (j & 1))) & 0xffffu, b = (vb[j >> 1] >> (16 * (j & 1))) & 0xffffu;
            *(LAS unsigned*)(Vt + (c0 + j) * LDP + 2 * lane) = a | (b << 16); } }
}
__device__ __forceinline__ void ret_a_item(const Args a, int item, LAS unsigned char* lds, int tid, int wave, int lane, int dry) {
    const bf16_t* PA = (const bf16_t*)(a.ws + WS_PA); const float* CS = (const float*)(a.ws + WS_CS); bf16_t* RS = (bf16_t*)(a.ws + WS_RS);
    const int b = item >> 6, h = (item >> 4) & 3, n = item & 15;
    LAS bf16_t* Kw = (LAS bf16_t*)lds; LAS bf16_t* Vn = Kw + 128 * LDP;
    const size_t row0 = (size_t)b * SEQ + n * 128;
    const float lg = log2f(1.0f - exp2f(-5.0f - (float)h));
    __syncthreads();
#pragma unroll
    for (int r = 0; r < 2; ++r) { const int task = tid + 512 * r, tok = task >> 3, c0 = 8 * (task & 7); const size_t row = row0 + tok;
        const float w = exp2f((float)(127 - tok) * lg);
        const u32x4 k0 = *(const u32x4*)(PA + row * NA + PA_K + 128 * h + c0), k1 = *(const u32x4*)(PA + row * NA + PA_K + 128 * h + c0 + 64);
        const f32x4* cp = (const f32x4*)(CS + (row * 64 + c0) * 2);
        u32x4 o0, o1;
#pragma unroll
        for (int jj = 0; jj < 4; ++jj) { const f32x4 c4 = cp[jj];
            const float x1a = bfe(k0, 2 * jj), x2a = bfe(k1, 2 * jj), x1b = bfe(k0, 2 * jj + 1), x2b = bfe(k1, 2 * jj + 1);
            o0[jj] = pk2((x1a * c4[0] - x2a * c4[1]) * w, (x1b * c4[2] - x2b * c4[3]) * w); o1[jj] = pk2((x1a * c4[1] + x2a * c4[0]) * w, (x1b * c4[3] + x2b * c4[2]) * w); }
        *(LAS u32x4*)(Kw + tok * LDP + c0) = o0; *(LAS u32x4*)(Kw + tok * LDP + c0 + 64) = o1; }
    ret_stage_vn(PA, row0, h, Vn, tid);
    __syncthreads();
    const int fr = lane & 15, fq = lane >> 4;
    bf16x8 Af[4];
#pragma unroll
    for (int ks = 0; ks < 4; ++ks) Af[ks] = frag_tr2(Kw, LDP, 32 * ks + 8 * fq, 32 * ks + 8 * fq + 4, 16 * wave, lane);
    bf16_t* outp = RS + (size_t)item * 16384;
#pragma unroll
    for (int eb = 0; eb < 8; ++eb) { f32x4 acc = (f32x4){0.f, 0.f, 0.f, 0.f};
#pragma unroll
        for (int ks = 0; ks < 4; ++ks) acc = mfma16(Af[ks], frag_tr2(Vn, LDP, 32 * ks + 8 * fq, 32 * ks + 8 * fq + 4, 16 * eb, lane), acc);
        u32x2 o; o.x = pk2(acc[0], acc[1]); o.y = pk2(acc[2], acc[3]);
        if (!dry) *(u32x2*)(outp + (16 * eb + fr) * 128 + 16 * wave + 4 * fq) = o; }
}
__device__ __forceinline__ void ret_scan(const Args a, int gtid, int gthreads, int dry) {
    bf16_t* RS = (bf16_t*)(a.ws + WS_RS);
    for (int idx = gtid; idx < 32 * 4096; idx += gthreads) { const int bh = idx >> 12, unit = idx & 4095, h = bh & 3;
        const float cd = exp2f(128.0f * log2f(1.0f - exp2f(-5.0f - (float)h)));
        u32x2* p = (u32x2*)(RS + (size_t)bh * 16 * 16384 + unit * 4);
        u32x2 v[16];
#pragma unroll
        for (int n = 0; n < 16; ++n) v[n] = p[(size_t)n * 4096];
        float s0 = 0.f, s1 = 0.f, s2 = 0.f, s3 = 0.f;
#pragma unroll
        for (int n = 0; n < 16; ++n) { u32x2 o; o.x = pk2(s0, s1); o.y = pk2(s2, s3); if (!dry) p[(size_t)n * 4096] = o;
            s0 = cd * s0 + bflo(v[n].x); s1 = cd * s1 + bfhi(v[n].x); s2 = cd * s2 + bflo(v[n].y); s3 = cd * s3 + bfhi(v[n].y); } }
}
__device__ __attribute__((noinline)) void retb_stage(const Args a, int item, LAS unsigned char* lds, int tid, int wave, int lane) {
    item = __builtin_amdgcn_readfirstlane(item); wave = __builtin_amdgcn_readfirstlane(wave);
    const bf16_t* PA = (const bf16_t*)(a.ws + WS_PA); const float* CS = (const float*)(a.ws + WS_CS); const bf16_t* RS = (const bf16_t*)(a.ws + WS_RS);
    const int b = item >> 6, h = (item >> 4) & 3, n = item & 15;
    LAS bf16_t* Kn = (LAS bf16_t*)lds; LAS bf16_t* Vt = Kn + 128 * LDP; LAS bf16_t* St = Vt + 128 * LDP;
    const size_t row0 = (size_t)b * SEQ + n * 128;
    __syncthreads();
#pragma unroll
    for (int r = 0; r < 2; ++r) { const int task = tid + 512 * r, tok = task >> 3, c0 = 8 * (task & 7); const size_t row = row0 + tok;
        const u32x4 k0 = *(const u32x4*)(PA + row * NA + PA_K + 128 * h + c0), k1 = *(const u32x4*)(PA + row * NA + PA_K + 128 * h + c0 + 64);
        const f32x4* cp = (const f32x4*)(CS + (row * 64 + c0) * 2);
        u32x4 o0, o1;
#pragma unroll
        for (int jj = 0; jj < 4; ++jj) { const f32x4 c4 = cp[jj];
            const float x1a = bfe(k0, 2 * jj), x2a = bfe(k1, 2 * jj), x1b = bfe(k0, 2 * jj + 1), x2b = bfe(k1, 2 * jj + 1);
            o0[jj] = pk2(x1a * c4[0] - x2a * c4[1], x1b * c4[2] - x2b * c4[3]); o1[jj] = pk2(x1a * c4[1] + x2a * c4[0], x1b * c4[3] + x2b * c4[2]); }
        *(LAS u32x4*)(Kn + tok * LDP + c0) = o0; *(LAS u32x4*)(Kn + tok * LDP + c0 + 64) = o1; asm volatile("" ::: "memory"); }
    ret_stage_vn(PA, row0, h, Vt, tid); asm volatile("" ::: "memory");
    { const bf16_t* sp = RS + (size_t)item * 16384;
#pragma unroll
      for (int r = 0; r < 4; ++r) { const int idx = tid + 512 * r, e = idx >> 4, c = idx & 15; *(LAS u32x4*)(St + e * LDP + 8 * c) = *(const u32x4*)(sp + e * 128 + 8 * c); } }
    __syncthreads();
}
__device__ __attribute__((noinline)) void retb_compute(const Args a, int item, LAS unsigned char* lds, int tid, int wave, int lane, int dry) {
    item = __builtin_amdgcn_readfirstlane(item); wave = __builtin_amdgcn_readfirstlane(wave);
    bf16_t* PA = (bf16_t*)(a.ws + WS_PA); const float* CS = (const float*)(a.ws + WS_CS);
    const int b = item >> 6, h = (item >> 4) & 3, n = item & 15;
    const LAS bf16_t* Kn = (const LAS bf16_t*)lds; const LAS bf16_t* Vt = Kn + 128 * LDP; const LAS bf16_t* St = Vt + 128 * LDP;
    const size_t row0 = (size_t)b * SEQ + n * 128;
    const float lg = log2f(1.0f - exp2f(-5.0f - (float)h));
    const int fr = lane & 15, fq = lane >> 4;
    const int iq = 16 * wave + fr; const size_t rowq = row0 + iq;
    u32x4 Qf[4];
    { u32x4 q[4];
#pragma unroll
      for (int ks = 0; ks < 4; ++ks) q[ks] = *(const u32x4*)(PA + rowq * NA + PA_Q + 128 * h + 32 * ks + 8 * fq);
      const float qs = 0.08838834764831845f;
#pragma unroll
      for (int ks = 0; ks < 2; ++ks) { const f32x4* cp = (const f32x4*)(CS + (rowq * 64 + 32 * ks + 8 * fq) * 2);
#pragma unroll
          for (int jj = 0; jj < 4; ++jj) { const f32x4 c4 = cp[jj];
              const float x1a = bfe(q[ks], 2 * jj), x2a = bfe(q[ks + 2], 2 * jj), x1b = bfe(q[ks], 2 * jj + 1), x2b = bfe(q[ks + 2], 2 * jj + 1);
              Qf[ks][jj] = pk2((x1a * c4[0] - x2a * c4[1]) * qs, (x1b * c4[2] - x2b * c4[3]) * qs);
              Qf[ks + 2][jj] = pk2((x1a * c4[1] + x2a * c4[0]) * qs, (x1b * c4[3] + x2b * c4[2]) * qs); } } }
    u32x4 P[4];
#pragma unroll
    for (int kk = 0; kk < 4; ++kk) P[kk] = (u32x4){0u, 0u, 0u, 0u};
#pragma unroll
    for (int jb = 0; jb < 8; ++jb) {
        if (jb <= wave) { f32x4 acc = (f32x4){0.f, 0.f, 0.f, 0.f};
#pragma unroll
            for (int ks = 0; ks < 4; ++ks) acc = mfma16(*(const LAS bf16x8*)(Kn + (16 * jb + fr) * LDP + 32 * ks + 8 * fq), as_frag(Qf[ks]), acc);
            float v[4];
#pragma unroll
            for (int r = 0; r < 4; ++r) { const int dij = iq - (16 * jb + 4 * fq + r); v[r] = dij >= 0 ? acc[r] * exp2f((float)dij * lg) : 0.f; }
            P[jb >> 1][(jb & 1) * 2] = pk2(v[0], v[1]); P[jb >> 1][(jb & 1) * 2 + 1] = pk2(v[2], v[3]); }
        asm volatile("" ::: "memory"); }
    { const float gi = exp2f((float)(iq + 1) * lg);
#pragma unroll
      for (int ks = 0; ks < 4; ++ks)
#pragma unroll
          for (int jj = 0; jj < 4; ++jj) Qf[ks][jj] = pk2(bflo(Qf[ks][jj]) * gi, bfhi(Qf[ks][jj]) * gi); }
    const int nkk = (wave + 2) >> 1;
    f32x4 o[8]; float s1 = 0.f;
#pragma unroll
    for (int eb = 0; eb < 8; ++eb) { f32x4 acc = (f32x4){0.f, 0.f, 0.f, 0.f};
#pragma unroll
        for (int ks = 0; ks < 4; ++ks) acc = mfma16(*(const LAS bf16x8*)(St + (16 * eb + fr) * LDP + 32 * ks + 8 * fq), as_frag(Qf[ks]), acc);
#pragma unroll
        for (int kk = 0; kk < 4; ++kk) if (kk < nkk) acc = mfma16(frag_tr2(Vt, LDP, 32 * kk + 4 * fq, 32 * kk + 16 + 4 * fq, 16 * eb, lane), as_frag(P[kk]), acc);
        o[eb] = acc; s1 += (acc[0] + acc[1]) + (acc[2] + acc[3]); asm volatile("" ::: "memory"); }
    s1 += xor16(s1); s1 += xor32(s1, lane);
    const float mean = s1 * (1.0f / 128.0f); float s2 = 0.f;
#pragma unroll
    for (int eb = 0; eb < 8; ++eb) { const f32x4 d = o[eb] - mean; s2 += (d[0] * d[0] + d[1] * d[1]) + (d[2] * d[2] + d[3] * d[3]); }
    s2 += xor16(s2); s2 += xor32(s2, lane);
    const float rstd = 1.0f / sqrtf(s2 * (1.0f / 128.0f) + EPS);
    bf16_t* gp = PA + rowq * NA + PA_G + 128 * h + 4 * fq;
#pragma unroll
    for (int eb = 0; eb < 8; ++eb) { const u32x2 g = *(const u32x2*)(gp + 16 * eb);
        const float y0 = (o[eb][0] - mean) * rstd * silu_f(bflo(g.x)), y1 = (o[eb][1] - mean) * rstd * silu_f(bfhi(g.x));
        const float y2 = (o[eb][2] - mean) * rstd * silu_f(bflo(g.y)), y3 = (o[eb][3] - mean) * rstd * silu_f(bfhi(g.y));
        u32x2 w; w.x = pk2(y0, y1); w.y = pk2(y2, y3); if (!dry) *(u32x2*)(gp + 16 * eb) = w; asm volatile("" ::: "memory"); }
}

constexpr int SSD_T0 = 105472, SSD_T1 = 109568, SSD_WT = 113664, SSD_SSQ = 129024, SSD_XW = 34816, SSD_RAW = 69632, SSD_XH = 69632, SSD_HH = 88064, XHP = 72;
__device__ __forceinline__ void ssd_stage_wtab(const float* cw, const float* cb, int g, LAS unsigned char* lds, int tid) {
    LAS float* wt = (LAS float*)(lds + SSD_WT);
    for (int i = tid; i < 5 * 768; i += 512) { const int k = i / 768, ci = i - 768 * k; const int ch = ci < 512 ? 512 * g + ci : (ci < 640 ? 1024 + 128 * g + (ci - 512) : 1280 + 128 * g + (ci - 640));
        wt[i] = k < 4 ? cw[k * 1536 + ch] : cb[ch]; }
}
template <int MODE>
__device__ __forceinline__ void ssd_tables(const Args a, int l, int b, int c, int g, LAS unsigned char* lds, int wave, int lane) {
    const float* DT = (const float*)(a.ws + WS_DT);
    LAS float* cst = (LAS float*)(lds + SSD_T0); LAS float* t1 = (LAS float*)(lds + SSD_T1);
    const int head = 8 * g + wave; const size_t row0 = (size_t)b * SEQ + 128 * c;
    const float A = -__expf(a.f(I_A_LOG)[l * 16 + head]);
    const float dt0 = DT[(row0 + 2 * lane) * 16 + head], dt1 = DT[(row0 + 2 * lane + 1) * 16 + head];
    const float a0 = dt0 * A, a1 = dt1 * A, s = a0 + a1;
    float v = s;
#pragma unroll
    for (int d = 1; d < 64; d <<= 1) { const float t = __builtin_bit_cast(float, __builtin_amdgcn_ds_bpermute((lane - d) << 2, __builtin_bit_cast(int, v))); if (lane >= d) v += t; }
    const float ex = v - s, cs0 = ex + a0, cs1 = ex + s;
    const float total = __builtin_bit_cast(float, __builtin_amdgcn_readlane(__builtin_bit_cast(int, v), 63));
    cst[wave * 128 + 2 * lane] = cs0; cst[wave * 128 + 2 * lane + 1] = cs1;
    if (MODE == 0) { t1[wave * 128 + 2 * lane] = dt0 * __expf(total - cs0); t1[wave * 128 + 2 * lane + 1] = dt1 * __expf(total - cs1);
        if (lane == 0) ((float*)(a.ws + WS_CD))[((size_t)b * 16 + c) * 16 + head] = __expf(total); }
    else { t1[wave * 128 + 2 * lane] = dt0; t1[wave * 128 + 2 * lane + 1] = dt1; }
}
__device__ __attribute__((noinline)) void ssda_prep(const Args a, int l, int item, LAS unsigned char* lds, int tid, int wave, int lane) {
    item = __builtin_amdgcn_readfirstlane(item); wave = __builtin_amdgcn_readfirstlane(wave); l = __builtin_amdgcn_readfirstlane(l);
    const int b = item >> 5, c = (item >> 1) & 15, g = item & 1;
    __syncthreads();
    ssd_stage_wtab(a.f(I_CONV_W) + (size_t)l * 4 * 1536, a.f(I_CONV_B) + (size_t)l * 1536, g, lds, tid);
    ssd_tables<0>(a, l, b, c, g, lds, wave, lane);
}
__device__ __attribute__((noinline)) void ssda_slab(const Args a, int item, int sl, LAS unsigned char* lds, int tid, int wave, int lane, int dry) {
    item = __builtin_amdgcn_readfirstlane(item); wave = __builtin_amdgcn_readfirstlane(wave); sl = __builtin_amdgcn_readfirstlane(sl);
    const int b = item >> 5, c = (item >> 1) & 15, g = item & 1;
    bf16_t* PA = (bf16_t*)(a.ws + WS_PA); const bf16_t* HB = (const bf16_t*)(a.ws + WS_HB); bf16_t* SS = (bf16_t*)(a.ws + WS_SS);
    LAS bf16_t* Bn = (LAS bf16_t*)lds; LAS bf16_t* Xw = (LAS bf16_t*)(lds + SSD_XW); LAS bf16_t* Raw = (LAS bf16_t*)(lds + SSD_RAW);
    const LAS float* wt = (const LAS float*)(lds + SSD_T1); const LAS float* taps = (const LAS float*)(lds + SSD_WT);
    const size_t row0 = (size_t)b * SEQ + 128 * c;
    const int chb = sl == 0 ? 1024 + 128 * g : (sl == 1 ? 1280 + 128 * g : 512 * g + 128 * (sl - 2));
    const int cib = sl == 0 ? 512 : (sl == 1 ? 640 : 128 * (sl - 2));
    __syncthreads();
#pragma unroll
    for (int r = 0; r < 5; ++r) { const int idx = tid + 512 * r, rr = idx >> 4, cc = idx & 15;
        if (rr < 131) { u32x4 v = (u32x4){0u, 0u, 0u, 0u};
            if (rr >= 3) v = *(const u32x4*)(PA + (row0 + rr - 3) * NA + PA_XBC + chb + 8 * cc);
            else if (c > 0) v = *(const u32x4*)(HB + (((row0 >> 7) - 1) * 3 + rr) * 1536 + chb + 8 * cc);
            *(LAS u32x4*)(Raw + rr * LDP + 8 * cc) = v; } }
    __syncthreads();
#pragma unroll
    for (int r = 0; r < 4; ++r) { const int idx = tid + 512 * r, tok = idx >> 4, cc = idx & 15;
        const LAS float* tp = taps + cib + 8 * cc;
        float o[8];
        { const f32x4 b0 = *(const LAS f32x4*)(tp + 4 * 768), b1 = *(const LAS f32x4*)(tp + 4 * 768 + 4);
#pragma unroll
          for (int j = 0; j < 4; ++j) { o[j] = b0[j]; o[4 + j] = b1[j]; } }
#pragma unroll
        for (int k = 0; k < 4; ++k) { const u32x4 rv = *(const LAS u32x4*)(Raw + (tok + k) * LDP + 8 * cc);
            const f32x4 w0 = *(const LAS f32x4*)(tp + k * 768), w1 = *(const LAS f32x4*)(tp + k * 768 + 4);
#pragma unroll
            for (int j = 0; j < 4; ++j) { o[j] += w0[j] * bfe(rv, j); o[4 + j] += w1[j] * bfe(rv, 4 + j); } }
#pragma unroll
        for (int j = 0; j < 8; ++j) o[j] = silu_f(o[j]);
        u32x4 pv; pv.x = pk2(o[0], o[1]); pv.y = pk2(o[2], o[3]); pv.z = pk2(o[4], o[5]); pv.w = pk2(o[6], o[7]);
        if (!dry) *(u32x4*)(PA + (row0 + tok) * NA + PA_XBC + chb + 8 * cc) = pv;
        if (sl == 0) *(LAS u32x4*)(Bn + tok * LDP + 8 * cc) = pv;
        if (sl >= 2) { const float w = wt[(2 * (sl - 2) + (cc >> 3)) * 128 + tok];
            u32x4 pw; pw.x = pk2(o[0] * w, o[1] * w); pw.y = pk2(o[2] * w, o[3] * w); pw.z = pk2(o[4] * w, o[5] * w); pw.w = pk2(o[6] * w, o[7] * w);
            *(LAS u32x4*)(Xw + tok * LDP + 8 * cc) = pw; } }
    if (sl < 2) return;
    __syncthreads();
    const int fr = lane & 15, fq = lane >> 4;
    bf16x8 Bf[4];
#pragma unroll
    for (int ks = 0; ks < 4; ++ks) Bf[ks] = frag_tr2(Xw, LDP, 32 * ks + 8 * fq, 32 * ks + 8 * fq + 4, 16 * wave, lane);
    const int head = 8 * g + 2 * (sl - 2) + (wave >> 2);
    bf16_t* outp = SS + (((size_t)b * 16 + c) * 16 + head) * 8192 + (16 * (wave & 3) + fr) * 128 + 4 * fq;
#pragma unroll 2
    for (int nb = 0; nb < 8; ++nb) { f32x4 acc = (f32x4){0.f, 0.f, 0.f, 0.f};
#pragma unroll
        for (int ks = 0; ks < 4; ++ks) acc = mfma16(frag_tr2(Bn, LDP, 32 * ks + 8 * fq, 32 * ks + 8 * fq + 4, 16 * nb, lane), Bf[ks], acc);
        u32x2 o; o.x = pk2(acc[0], acc[1]); o.y = pk2(acc[2], acc[3]);
        if (!dry) *(u32x2*)(outp + 16 * nb) = o; }
}
__device__ __forceinline__ void ssd_scan(const Args a, int gtid, int gthreads, int dry) {
    bf16_t* SS = (bf16_t*)(a.ws + WS_SS); const float* CD = (const float*)(a.ws + WS_CD);
    for (int idx = gtid; idx < 8 * 16 * 2048; idx += gthreads) { const int bb = idx >> 15, head = (idx >> 11) & 15, unit = idx & 2047;
        u32x2* p = (u32x2*)(SS + ((size_t)bb * 256 + head) * 8192 + unit * 4);
        const float* cdp = CD + (size_t)bb * 256 + head;
        u32x2 v[16]; float cd[16];
#pragma unroll
        for (int c = 0; c < 16; ++c) { v[c] = p[(size_t)c * 16 * 2048]; cd[c] = cdp[c * 16]; }
        float s0 = 0.f, s1 = 0.f, s2 = 0.f, s3 = 0.f;
#pragma unroll
        for (int c = 0; c < 16; ++c) { u32x2 o; o.x = pk2(s0, s1); o.y = pk2(s2, s3); if (!dry) p[(size_t)c * 16 * 2048] = o;
            s0 = cd[c] * s0 + bflo(v[c].x); s1 = cd[c] * s1 + bfhi(v[c].x); s2 = cd[c] * s2 + bflo(v[c].y); s3 = cd[c] * s3 + bfhi(v[c].y); } }
}
__device__ __attribute__((noinline)) void ssdb_prep(const Args a, int l, int item, LAS unsigned char* lds, int tid, int wave, int lane) {
    item = __builtin_amdgcn_readfirstlane(item); wave = __builtin_amdgcn_readfirstlane(wave); l = __builtin_amdgcn_readfirstlane(l);
    const int b = item >> 5, c = (item >> 1) & 15, g = item & 1;
    const bf16_t* PA = (const bf16_t*)(a.ws + WS_PA);
    LAS bf16_t* Bn = (LAS bf16_t*)lds;
    const size_t row0 = (size_t)b * SEQ + 128 * c;
    __syncthreads();
    ssd_tables<1>(a, l, b, c, g, lds, wave, lane);
#pragma unroll
    for (int r = 0; r < 8; ++r) { const int idx = tid + 512 * r, which = idx >> 11, tok = (idx >> 4) & 127, cc = idx & 15;
        *(LAS u32x4*)(Bn + (which * 128 + tok) * LDP + 8 * cc) = *(const u32x4*)(PA + (row0 + tok) * NA + PA_XBC + 1024 + 256 * which + 128 * g + 8 * cc); }
}
__device__ __attribute__((noinline)) void ssdb_gt(LAS unsigned char* lds, int tid, int wave, int lane) {
    wave = __builtin_amdgcn_readfirstlane(wave);
    const LAS bf16_t* Bn = (const LAS bf16_t*)lds; const LAS bf16_t* Cn = Bn + 128 * LDP;
    const int fr = lane & 15, fq = lane >> 4;
    __syncthreads();
    u32x2 GT[8];
    bf16x8 Cf[4];
#pragma unroll
    for (int ks = 0; ks < 4; ++ks) Cf[ks] = *(const LAS bf16x8*)(Cn + (16 * wave + fr) * LDP + 32 * ks + 8 * fq);
#pragma unroll
    for (int sb = 0; sb < 8; ++sb) { f32x4 acc = (f32x4){0.f, 0.f, 0.f, 0.f};
        if (sb <= wave) {
#pragma unroll
            for (int ks = 0; ks < 4; ++ks) acc = mfma16(*(const LAS bf16x8*)(Bn + (16 * sb + fr) * LDP + 32 * ks + 8 * fq), Cf[ks], acc); }
        GT[sb].x = pk2(acc[0], acc[1]); GT[sb].y = pk2(acc[2], acc[3]); }
    __syncthreads();
#pragma unroll
    for (int sb = 0; sb < 8; ++sb) *(LAS u32x2*)(lds + (sb * 512 + tid) * 8) = GT[sb];
}
__device__ __attribute__((noinline)) void ssdb_head(const Args a, int l, int item, int hh, LAS unsigned char* lds, int tid, int wave, int lane, int dry) {
    item = __builtin_amdgcn_readfirstlane(item); wave = __builtin_amdgcn_readfirstlane(wave); l = __builtin_amdgcn_readfirstlane(l); hh = __builtin_amdgcn_readfirstlane(hh);
    const int b = item >> 5, c = (item >> 1) & 15, g = item & 1, head = 8 * g + hh;
    bf16_t* PA = (bf16_t*)(a.ws + WS_PA); const bf16_t* SS = (const bf16_t*)(a.ws + WS_SS); float* SSQ = (float*)(a.ws + WS_SSQ);
    const LAS bf16_t* Cn = (const LAS bf16_t*)lds + 128 * LDP; LAS bf16_t* xh = (LAS bf16_t*)(lds + SSD_XH); LAS bf16_t* Hh = (LAS bf16_t*)(lds + SSD_HH);
    const LAS float* cst = (const LAS float*)(lds + SSD_T0); const LAS float* dtt = (const LAS float*)(lds + SSD_T1);
    const size_t row0 = (size_t)b * SEQ + 128 * c;
    const int fr = lane & 15, fq = lane >> 4, lcol = 16 * wave + fr; const size_t rowl = row0 + lcol;
    const int nkk = (wave + 2) >> 1;
    u32x4 gx[2], gh[2];
    { const bf16_t* sp = SS + (((size_t)b * 16 + c) * 16 + head) * 8192;
#pragma unroll
      for (int r = 0; r < 2; ++r) { const int idx = tid + 512 * r; gx[r] = *(const u32x4*)(PA + (row0 + (idx >> 3)) * NA + PA_XBC + 64 * head + 8 * (idx & 7)); gh[r] = *(const u32x4*)(sp + (idx >> 4) * 128 + 8 * (idx & 15)); } }
    __syncthreads();
#pragma unroll
    for (int r = 0; r < 2; ++r) { const int idx = tid + 512 * r; *(LAS u32x4*)(xh + (idx >> 3) * XHP + 8 * (idx & 7)) = gx[r]; *(LAS u32x4*)(Hh + (idx >> 4) * LDP + 8 * (idx & 15)) = gh[r]; }
    __syncthreads();
    const float csl = cst[hh * 128 + lcol], ecl = __expf(csl), Dh = a.f(I_SSM_D)[l * 16 + head];
    u32x4 Pm[4];
#pragma unroll
    for (int kk = 0; kk < 4; ++kk) Pm[kk] = (u32x4){0u, 0u, 0u, 0u};
#pragma unroll
    for (int sb = 0; sb < 8; ++sb) {
        if (sb <= wave) { const f32x4 cs4 = *(const LAS f32x4*)(cst + hh * 128 + 16 * sb + 4 * fq), dt4 = *(const LAS f32x4*)(dtt + hh * 128 + 16 * sb + 4 * fq);
            const u32x2 gp = *(const LAS u32x2*)(lds + (sb * 512 + tid) * 8);
            const float gt[4] = {bflo(gp.x), bfhi(gp.x), bflo(gp.y), bfhi(gp.y)};
            float v[4];
#pragma unroll
            for (int r = 0; r < 4; ++r) { const int sidx = 16 * sb + 4 * fq + r; v[r] = sidx <= lcol ? gt[r] * __expf(csl - cs4[r]) * dt4[r] : 0.f; }
            Pm[sb >> 1][(sb & 1) * 2] = pk2(v[0], v[1]); Pm[sb >> 1][(sb & 1) * 2 + 1] = pk2(v[2], v[3]); } }
    float ssq = 0.f;
    bf16_t* zp = PA + rowl * NA + PA_Z + 64 * head + 4 * fq;
#pragma unroll
    for (int pb = 0; pb < 4; ++pb) { f32x4 yd = (f32x4){0.f, 0.f, 0.f, 0.f}, yo = (f32x4){0.f, 0.f, 0.f, 0.f};
#pragma unroll
        for (int kk = 0; kk < 4; ++kk) if (kk < nkk) yd = mfma16(frag_tr2(xh, XHP, 32 * kk + 4 * fq, 32 * kk + 16 + 4 * fq, 16 * pb, lane), as_frag(Pm[kk]), yd);
#pragma unroll
        for (int ks = 0; ks < 4; ++ks) yo = mfma16(*(const LAS bf16x8*)(Hh + (16 * pb + fr) * LDP + 32 * ks + 8 * fq), *(const LAS bf16x8*)(Cn + (16 * wave + fr) * LDP + 32 * ks + 8 * fq), yo);
        const u32x2 z = *(const u32x2*)(zp + 16 * pb), xv = *(const LAS u32x2*)(xh + lcol * XHP + 16 * pb + 4 * fq);
        float y[4];
        y[0] = (yd[0] + ecl * yo[0] + Dh * bflo(xv.x)) * silu_f(bflo(z.x)); y[1] = (yd[1] + ecl * yo[1] + Dh * bfhi(xv.x)) * silu_f(bfhi(z.x));
        y[2] = (yd[2] + ecl * yo[2] + Dh * bflo(xv.y)) * silu_f(bflo(z.y)); y[3] = (yd[3] + ecl * yo[3] + Dh * bfhi(xv.y)) * silu_f(bfhi(z.y));
        ssq += (y[0] * y[0] + y[1] * y[1]) + (y[2] * y[2] + y[3] * y[3]);
        u32x2 w; w.x = pk2(y[0], y[1]); w.y = pk2(y[2], y[3]); if (!dry) *(u32x2*)(zp + 16 * pb) = w;
        asm volatile("" ::: "memory"); }
    ssq += xor16(ssq); ssq += xor32(ssq, lane);
    if (fq == 0) { LAS float* sa = (LAS float*)(lds + SSD_SSQ) + lcol; const float tot = (hh == 0 ? 0.f : *sa) + ssq;
        if (hh == 7) { if (!dry) SSQ[rowl * 2 + g] = tot; } else *sa = tot; }
}
__device__ __attribute__((noinline)) void phase_mix_a(const Args a, int l, LAS unsigned char* lds, int bid, int nblk, int tid, int wave, int lane, int dry) {
    bid = __builtin_amdgcn_readfirstlane(bid); nblk = __builtin_amdgcn_readfirstlane(nblk); wave = __builtin_amdgcn_readfirstlane(wave);
    for (int item = bid; item < 512; item += nblk) ret_a_item(a, item, lds, tid, wave, lane, dry);
}
__device__ __attribute__((noinline)) void phase_mix_scan(const Args a, int l, LAS unsigned char* lds, int bid, int nblk, int tid, int wave, int lane, int dry) {
    ret_scan(a, bid * 512 + tid, nblk * 512, dry);
    ssd_scan(a, bid * 512 + tid, nblk * 512, dry);
}
__device__ __attribute__((noinline)) void phase_final(const Args a, int bid, int nblk, int wave, int lane) {
    const int gw = bid * 8 + wave, NGW = nblk * 8;
    for (int tok = gw; tok < T; tok += NGW) {
        f32x4* xr = (f32x4*)(a.out + (size_t)tok * D) + lane;
        f32x4 v[4]; float s = 0.f;
#pragma unroll
        for (int j = 0; j < 4; ++j) { v[j] = xr[64 * j]; s += (v[j][0] * v[j][0] + v[j][1] * v[j][1]) + (v[j][2] * v[j][2] + v[j][3] * v[j][3]); }
        const float rstd = 1.0f / sqrtf(wave_sum(s) * (1.0f / D) + EPS);
#pragma unroll
        for (int j = 0; j < 4; ++j) { const f32x4 g = *(const f32x4*)(a.f(I_FINAL_G) + 4 * lane + 256 * j); xr[64 * j] = (v[j] * rstd) * g; }
    }
}

__device__ __attribute__((noinline)) void rstd_rows(const Args a, int gtid, int gthreads) {
    float* sq = (float*)(a.ws + WS_SSQ);
    for (int row = gtid; row < T; row += gthreads) sq[2 * T + row] = 1.0f / sqrtf((sq[2 * row] + sq[2 * row + 1]) * (1.0f / 1024.0f) + EPS);
}
constexpr int NPHASE = 18;
__global__ void __launch_bounds__(512, 2) mk_fwd(KArgs ka) {
    extern __shared__ __attribute__((aligned(16))) unsigned char lds_raw[];
    LAS unsigned char* lds = (LAS unsigned char*)lds_raw;
    const int tid0 = threadIdx.x, wave = __builtin_amdgcn_readfirstlane(tid0 >> 6);
    const int bid = blockIdx.x, nblk = gridDim.x;
    volatile LAS unsigned* MISC = (volatile LAS unsigned*)(lds + MISC_OFF);
    for (int u = tid0; u < (LDS_BYTES - RING_BYTES) / 4; u += 512) ((LAS unsigned*)(lds + RING_BYTES))[u] = 0u;
    __syncthreads();
    if (tid0 == 0) {
#pragma unroll
        for (int i = 0; i < 19; ++i) { const unsigned long long v = (unsigned long long)ka.in[i]; ((LAS unsigned*)(lds + ARGS_OFF))[2 * i] = (unsigned)v; ((LAS unsigned*)(lds + ARGS_OFF))[2 * i + 1] = (unsigned)(v >> 32); } }
    __syncthreads();
    unsigned* ctl = (unsigned*)(ka.ws + WS_CTL);
    XcdBarrier bar; bar.bar = ctl + CW_BAR; bar.x = 0; bar.st = nullptr;
    if (!MK_SPLIT) bar = xcd_barrier_post(ctl + CW_BAR, MISC + 8);
    const int lo = ka.ph_lo, hi = ka.ph_hi;
#pragma unroll 1
    for (int it = lo; it < hi + (MK_REP_PH >= 0 ? MK_REP_N : 0); ++it) {
        const int ph = (MK_REP_PH < 0 || it <= MK_REP_PH) ? it : (it - MK_REP_N > MK_REP_PH ? it - MK_REP_N : MK_REP_PH);
        int tid = tid0; asm volatile("" : "+v"(tid)); const int lane = tid & 63;
        const int dry = (MK_REP_PH >= 0 && it > MK_REP_PH && it <= MK_REP_PH + MK_REP_N) ? 1 : 0;
        Args a; a.lds = lds; a.out = ka.out; a.ws = ka.ws; asm volatile("" : "+s"(a.ws), "+s"(a.out));
        bf16_t* PA = (bf16_t*)(a.ws + WS_PA); bf16_t* H = (bf16_t*)(a.ws + WS_H);
        const bf16_t* WinT = (const bf16_t*)(a.ws + WS_WIN); const bf16_t* WbrT = (const bf16_t*)(a.ws + WS_WBR); const bf16_t* WoutT = (const bf16_t*)(a.ws + WS_WOUT);
        const int l = ph >= 9 ? 1 : 0, k = ph - 1 - 8 * l;
        const float* xcur = l == 0 ? a.f(I_X) : a.out;
        if (ph == 0) { phase_p0(a, lds, bid, nblk, tid, wave, lane); __syncthreads(); convert_weights(a, 0, lds, bid * 8 + wave, nblk * 8, wave, lane); }
        else if (ph == 17) { phase_final(a, bid, nblk, wave, lane); }
        else if (k == 0) { if (l > 0) convert_weights(a, l, lds, bid * 8 + wave, nblk * 8, wave, lane); phase_hprep(a, l, xcur, lds, bid, nblk, tid, wave, lane); }
        else if (k == 1) { pg8::Gemm g{H, 1024, WinT, T, N1A, 1024}; pg8::StaticOrder S; S.init(T, N1A, nblk, bid); EpiIn1 E{PA, (bf16_t*)(a.ws + WS_HB)}; pg8::gemm_phase(lds, g, S, E, pg8::AMapLinear{}); }
        else if (k == 2) { phase_mix_a(a, l, lds, bid, nblk, tid, wave, lane, dry);
            for (int item = bid; item < 256; item += nblk) { ssda_prep(a, l, item, lds, tid, wave, lane); for (int sl = 0; sl < 6; ++sl) ssda_slab(a, item, sl, lds, tid, wave, lane, dry); } }
        else if (k == 3) { phase_mix_scan(a, l, lds, bid, nblk, tid, wave, lane, dry); }
        else if (k == 4) {
            sc_items(a, l, bid, nblk, tid, dry);
            for (int item = bid; item < 512; item += nblk) { retb_stage(a, item, lds, tid, wave, lane); retb_compute(a, item, lds, tid, wave, lane, dry); }
            for (int item = bid; item < 256; item += nblk) { ssdb_prep(a, l, item, lds, tid, wave, lane); ssdb_gt(lds, tid, wave, lane);
                for (int hh = 0; hh < 8; ++hh) ssdb_head(a, l, item, hh, lds, tid, wave, lane, dry); } }
        else if (k == 5) {
            pg8::Gemm g{H, 1024, WinT + (size_t)N1A * 1024, T, N1B, 1024}; pg8::StaticOrder S; S.init(T, N1B, nblk, bid); EpiIn2 E{PA, (const float*)(a.ws + WS_SSQ)}; pg8::gemm_phase(lds, g, S, E, pg8::AMapLinear{}); }
        else if (k == 6) { pg8::Gemm g{PA, NA, WbrT, T, 1024, 2048}; pg8::StaticOrder S; S.init(T, 1024, nblk, bid); EpiMerge E{PA, H}; pg8::gemm_phase(lds, g, S, E, pg8::AMapBranch{}); }
        else { pg8::Gemm g{H, 1024, WoutT, T, 1024, 1024}; pg8::StaticOrder S; S.init(T, 1024, nblk, bid);
            EpiOut E{xcur, a.out, (const float*)(a.ws + WS_ADA) + (size_t)l * 8 * 3072 + 2048}; pg8::gemm_phase(lds, g, S, E, pg8::AMapLinear{}); }
        if (!MK_SPLIT && it + 1 < hi + (MK_REP_PH >= 0 ? MK_REP_N : 0)) xcd_barrier(bar);
    }
}

extern "C" void kernel_launch(void* const* d_in, const int* in_sizes, int n_in, void* d_out, int out_size, void* d_ws, size_t ws_size, hipStream_t stream) {
    static int grid = 0;
    if (grid == 0) {
        if (n_in != 19 || in_sizes[0] != T * D || out_size != T * D || ws_size < WS_END) { fprintf(stderr, "kernel_launch: unexpected shapes (n_in %d, in0 %d, out %d, ws %zu, need %zu)\n", n_in, n_in > 0 ? in_sizes[0] : -1, out_size, ws_size, (size_t)WS_END); grid = -1; return; }
        int dev = 0, cus = 0, per_cu = 0;
        if (hipGetDevice(&dev) != hipSuccess || hipDeviceGetAttribute(&cus, hipDeviceAttributeMultiprocessorCount, dev) != hipSuccess) { grid = -1; return; }
        if (hipFuncSetAttribute((const void*)mk_fwd, hipFuncAttributeMaxDynamicSharedMemorySize, LDS_BYTES) != hipSuccess) { fprintf(stderr, "kernel_launch: hipFuncSetAttribute failed\n"); grid = -1; return; }
        if (hipOccupancyMaxActiveBlocksPerMultiprocessor(&per_cu, (const void*)mk_fwd, 512, LDS_BYTES) != hipSuccess || per_cu < 1) { fprintf(stderr, "kernel_launch: occupancy query says %d blocks per CU\n", per_cu); }
        (void)hipGetLastError();
        grid = cus;
        if (grid != 256) fprintf(stderr, "kernel_launch: %d CUs (built for 256)\n", grid);
    }
    if (grid < 0) return;
    (void)hipMemsetAsync((char*)d_ws + WS_CTL, 0, CTL_BYTES, stream);
    KArgs a{};
    for (int i = 0; i < 19; ++i) a.in[i] = d_in[i];
    a.out = (float*)d_out; a.ws = (unsigned char*)d_ws;
#if MK_SPLIT
    for (int ph = 0; ph < NPHASE && ph < MK_PH_HI; ++ph) { a.ph_lo = ph; a.ph_hi = ph + 1; hipLaunchKernelGGL(mk_fwd, dim3(grid), dim3(512), LDS_BYTES, stream, a); }
#else
    a.ph_lo = 0; a.ph_hi = NPHASE;
    hipLaunchKernelGGL(mk_fwd, dim3(grid), dim3(512), LDS_BYTES, stream, a);
#endif
}
```

```cpp
#include <hip/hip_runtime.h>
#include <cstdio>
#include <cstdint>

#ifndef MK_SPLIT
#define MK_SPLIT 0
#endif
#ifndef MK_OFF
#define MK_OFF 0
#endif
#ifndef MK_SC1
#define MK_SC1 1
#endif
#ifndef MK_SUB
#define MK_SUB 255
#endif
#ifndef MK_REP_PH
#define MK_REP_PH -1
#endif
#ifndef MK_REP_N
#define MK_REP_N 2
#endif
#ifndef MK_PH_HI
#define MK_PH_HI 1000
#endif

#define LAS __attribute__((address_space(3)))
#define GAS __attribute__((address_space(1)))
typedef unsigned short bf16_t;
typedef short bf16x8 __attribute__((ext_vector_type(8)));
typedef float f32x4 __attribute__((ext_vector_type(4)));
typedef float f32x2 __attribute__((ext_vector_type(2)));
typedef unsigned u32x4 __attribute__((ext_vector_type(4)));
typedef unsigned u32x2 __attribute__((ext_vector_type(2)));

constexpr int BATCH = 8, SEQ = 2048, D = 1024, T = BATCH * SEQ, DEPTH = 2;
constexpr int IN_W = 9744;
constexpr int C_RQ = 0, C_RK = 512, C_RV = 1024, C_RG = 1536, C_SZ = 2048, C_XBC = 3072, C_DT = 4608, C_CB = 4624, C_CC = 5136, C_CH = 5648, C_CG = 6160, C_MG = 6672;
constexpr int NA = 5632;
constexpr int PA_Q = 0, PA_K = 512, PA_V = 1024, PA_G = 1536, PA_Z = 2048, PA_XBC = 3072, PA_U = 4608, PA_W = 5120;
constexpr int N1A = 26 * 256, N1B = 12 * 256, NW1 = N1A + N1B;
constexpr float EPS = 1e-6f;

constexpr size_t WS_CTL = 0, CTL_BYTES = 1u << 20;
constexpr size_t WS_ADA = WS_CTL + CTL_BYTES;
constexpr size_t WS_CS = WS_ADA + (size_t)2 * 8 * 3072 * 4;
constexpr size_t WS_DT = WS_CS + (size_t)T * 64 * 2 * 4;
constexpr size_t WS_SSQ = WS_DT + (size_t)T * 16 * 4;
constexpr size_t WS_WIN = WS_SSQ + (size_t)T * 16 * 4;
constexpr size_t WS_WBR = WS_WIN + (size_t)NW1 * 1024 * 2;
constexpr size_t WS_WOUT = WS_WBR + (size_t)1024 * 2048 * 2;
constexpr size_t WS_H = WS_WOUT + (size_t)1024 * 1024 * 2;
constexpr size_t WS_PA = WS_H + (size_t)T * 1024 * 2;
constexpr size_t WS_RS = WS_PA + (size_t)T * NA * 2;
constexpr size_t WS_SS = WS_RS + (size_t)512 * 128 * 128 * 2;
constexpr size_t WS_CD = WS_SS + (size_t)2048 * 64 * 128 * 2;
constexpr size_t WS_WDT = WS_CD + (size_t)2048 * 4;
constexpr size_t WS_HB = WS_WDT + (size_t)2 * 16 * 1024 * 2;
constexpr size_t WS_END = WS_HB + (size_t)(T / 128) * 3 * 1536 * 2;
static_assert(WS_END <= 319291392ull, "workspace");

constexpr int CW_BAR = 4096;
constexpr int CW_SEAM = 16384;

constexpr int RING_BYTES = 131072;
constexpr int MISC_OFF = RING_BYTES + 320;
constexpr int LDS_BYTES = 147456;

#define LDS_WAIT() asm volatile("s_waitcnt lgkmcnt(0)" ::: "memory")
#define VM_WAIT() asm volatile("s_waitcnt vmcnt(0)" ::: "memory")
__device__ __forceinline__ unsigned f2bf(float f) { unsigned u = __builtin_bit_cast(unsigned, f); return (u + 0x7fffu + ((u >> 16) & 1u)) >> 16; }
__device__ __forceinline__ unsigned pk2(float lo, float hi) { return f2bf(lo) | (f2bf(hi) << 16); }
__device__ __forceinline__ float bf2f(unsigned short b) { return __builtin_bit_cast(float, ((unsigned)b) << 16); }
__device__ __forceinline__ float bflo(unsigned w) { return __builtin_bit_cast(float, w << 16); }
__device__ __forceinline__ float bfhi(unsigned w) { return __builtin_bit_cast(float, w & 0xffff0000u); }
__device__ __forceinline__ float bfe(const u32x4 v, int j) { const unsigned w = v[j >> 1]; return (j & 1) ? bfhi(w) : bflo(w); }
#define SWZ_XOR(v, m) __builtin_bit_cast(float, __builtin_amdgcn_ds_swizzle(__builtin_bit_cast(int, (v)), (((m) << 10) | 0x1f)))
__device__ __forceinline__ float wave_sum(float v) {
    v += SWZ_XOR(v, 1); v += SWZ_XOR(v, 2); v += SWZ_XOR(v, 4); v += SWZ_XOR(v, 8); v += SWZ_XOR(v, 16);
    return __builtin_bit_cast(float, __builtin_amdgcn_readlane(__builtin_bit_cast(int, v), 0)) + __builtin_bit_cast(float, __builtin_amdgcn_readlane(__builtin_bit_cast(int, v), 32));
}
__device__ __forceinline__ float xor16(float v) { return SWZ_XOR(v, 16); }
__device__ __forceinline__ float xor32(float v, int lane) { return __builtin_bit_cast(float, __builtin_amdgcn_ds_bpermute((lane ^ 32) << 2, __builtin_bit_cast(int, v))); }
__device__ __forceinline__ float silu_f(float x) { return x / (1.0f + __expf(-x)); }

#define XB_TMO      128
#define XB_XCNT(j)  (256  + 64 * (j))
#define XB_XSUB(j)  (1280 + 64 * (j))
#define XB_XGEN(j)  (2304 + 64 * (j))
#define XB_TOP      3328
#define XB_TOPGEN   3392
#define XCD_BAR_WORDS 3456
#define XB_SPIN_CAP (1u << 18)
__device__ __forceinline__ unsigned xb_ld(unsigned* p)              { return __hip_atomic_load(p, __ATOMIC_RELAXED, __HIP_MEMORY_SCOPE_AGENT); }
__device__ __forceinline__ unsigned xb_add(unsigned* p, unsigned v) { return __hip_atomic_fetch_add(p, v, __ATOMIC_RELAXED, __HIP_MEMORY_SCOPE_AGENT); }
__device__ __forceinline__ unsigned xb_xcc_id() { return (unsigned)__builtin_amdgcn_s_getreg((3 << 11) | 20) & 0xFu; }
#define XB_SPIN(cond, bar) do { unsigned _sp = 0; while (cond) { __builtin_amdgcn_s_sleep(1); \
    if ((++_sp & 255u) == 0u) { if (xb_ld(&(bar)[XB_TMO])) break; if (_sp > XB_SPIN_CAP) { atomicAdd(&(bar)[XB_TMO], 1u); break; } } } } while (0)
struct XcdBarrier { unsigned* bar; unsigned x; volatile LAS unsigned* st; };
__device__ __forceinline__ XcdBarrier xcd_barrier_post(unsigned* bar, volatile LAS unsigned* st) {
    XcdBarrier b; b.bar = bar; b.x = xb_xcc_id(); b.st = st;
    if (threadIdx.x == 0) (void)xb_add(&bar[XB_XCNT(b.x)], 1u);
    return b;
}
__device__ __forceinline__ void xcd_barrier_complete(unsigned* bar, unsigned x, unsigned& nloc, unsigned& nx) {
    const unsigned G = gridDim.x * gridDim.y * gridDim.z;
    unsigned sum, cnt, mine, sp = 0u;
    for (;;) {
        sum = 0u; cnt = 0u; mine = 0u;
#pragma unroll 1
        for (unsigned j = 0; j < 16; ++j) { const unsigned c = xb_ld(&bar[XB_XCNT(j)]); sum += c; cnt += (c > 0u) ? 1u : 0u; mine = (j == x) ? c : mine; }
        if (sum == G) break;
        __builtin_amdgcn_s_sleep(1);
        if ((++sp & 255u) == 0u) { if (xb_ld(&bar[XB_TMO])) break; if (sp > XB_SPIN_CAP) { atomicAdd(&bar[XB_TMO], 1u); break; } }
    }
    nloc = mine > 0u ? mine : 1u; nx = cnt > 0u ? cnt : 1u;
}
__device__ __forceinline__ void xcd_barrier(const XcdBarrier& b) {
    asm volatile("s_waitcnt vmcnt(0)" ::: "memory");
    __syncthreads();
    if (threadIdx.x == 0) {
        unsigned* bar = b.bar;
        __builtin_amdgcn_s_waitcnt(0);
        unsigned nloc = b.st[0], nx = b.st[1];
        if (nloc == 0u) { xcd_barrier_complete(bar, b.x, nloc, nx); b.st[0] = nloc; b.st[1] = nx; }
        const unsigned old = xb_add(&bar[XB_XSUB(b.x)], 1u);
        const unsigned gen = old / nloc;
        if (old + 1u == (gen + 1u) * nloc) {
            __builtin_amdgcn_fence(__ATOMIC_RELEASE, "agent");
            asm volatile("s_waitcnt vmcnt(0)" ::: "memory");
            const unsigned og = xb_add(&bar[XB_TOP], 1u);
            const unsigned tg = og / nx;
            if (og + 1u == (tg + 1u) * nx) xb_add(&bar[XB_TOPGEN], 1u);
            else XB_SPIN(xb_ld(&bar[XB_TOPGEN]) == tg, bar);
            __builtin_amdgcn_fence(__ATOMIC_ACQUIRE, "agent");
            xb_add(&bar[XB_XGEN(b.x)], 1u);
            asm volatile("s_waitcnt vmcnt(0)" ::: "memory");
        } else {
            XB_SPIN(xb_ld(&bar[XB_XGEN(b.x)]) == gen, bar);
            __builtin_amdgcn_fence(__ATOMIC_ACQUIRE, "agent");
            asm volatile("s_waitcnt vmcnt(0)" ::: "memory");
        }
    }
    __syncthreads();
}

namespace pg8 {
constexpr int BM = 256, BK = 64, HALF = 128, HTB = HALF * BK * 2, STAGE_BYTES = 8 * HTB, NXCD = 8, WGM = 8;
__host__ __device__ __forceinline__ int lds_byte(int r, int c) { const int st = (r >> 4) * 2 + (c >> 5), rr = r & 15, cc = c & 31, ob = rr * 64 + cc * 2; return st * 1024 + (ob ^ (((ob >> 9) & 1) << 5)); }
__host__ __device__ __forceinline__ void stage_rc(int b, int& R, int& C) { const int st = b / 1024, sb = b % 1024, swz = sb ^ (((sb >> 9) & 1) << 5); R = (st >> 1) * 16 + swz / 64; C = (st & 1) * 32 + (swz % 64) / 2; }
__host__ __device__ __forceinline__ int perm32(int rho) { const int n = rho >> 4, i = rho & 15; return 8 * (i >> 2) + 4 * n + (i & 3); }
struct Unit { int pm, pn; };
struct Gemm { const bf16_t* A; int lda; const bf16_t* Bt; int M, N, K; };
struct StaticOrder {
    int nM, nN, nwg, G, c;
    __device__ void init(int M, int N, int G_, int c_) { nM = M / BM; nN = N / BM; nwg = nM * nN; G = G_; c = c_; }
    __device__ bool next(int i, Unit& u) const {
        const long L = (long)i * G + c; if (L >= nwg) return false;
        int wgid = (int)L; { const int q = nwg / NXCD, r = nwg % NXCD, xcd = wgid % NXCD, off = wgid / NXCD; wgid = (xcd < r ? xcd * (q + 1) : r * (q + 1) + (xcd - r) * q) + off; }
        const int nig = WGM * nN, gid = wgid / nig, fm = gid * WGM, gsz = (nM - fm) < WGM ? (nM - fm) : WGM;
        u.pm = fm + ((wgid % nig) % gsz); u.pn = (wgid % nig) / gsz; return true;
    }
};
struct GateOrder { int pm, pn; __device__ __forceinline__ bool next(int i, Unit& u) const { if (i >= 3) return false; u.pm = pm; u.pn = 4 * i + pn; return true; } };
__device__ __forceinline__ unsigned cvt_pk_bf16(float lo, float hi) { unsigned r; asm volatile("v_cvt_pk_bf16_f32 %0, %1, %2" : "=v"(r) : "v"(lo), "v"(hi)); return r; }

struct AMapLinear { static constexpr int NSEG = 1; __device__ __forceinline__ int seg_end(int, int nt) const { return nt; } __device__ __forceinline__ size_t koff(int t) const { return (size_t)t * (BK * 2); } };
struct AMapBranch { static constexpr int NSEG = 3; __device__ __forceinline__ int seg_end(int sg, int) const { return sg == 0 ? 16 : (sg == 1 ? 24 : 32); } __device__ __forceinline__ size_t koff(int t) const { const int col = t < 16 ? PA_Z + 64 * t : (t < 24 ? PA_G + 64 * (t - 16) : PA_W + 64 * (t - 24)); return (size_t)col * 2; } };

template <class Epi, class AMap, class Sched>
__device__ __forceinline__ void gemm_phase(LAS unsigned char* lds, const Gemm g, const Sched& S, const Epi& E, const AMap AM) {
    int tid = threadIdx.x; asm volatile("" : "+v"(tid));
    const int wid = __builtin_amdgcn_readfirstlane(tid >> 6), lane = tid & 63, wr = wid >> 2, wc = wid & 3, fr = lane & 15, fq = lane >> 4;
    const int K = g.K, nt = K / BK;
    unsigned voffA[2], voffB[2];
#pragma unroll
    for (int i = 0; i < 2; ++i) { int R, C; stage_rc(tid * 16 + i * 8192, R, C); const int Rb = Epi::PERM ? ((R & ~31) + perm32(R & 31)) : R;
        voffA[i] = (unsigned)(R * g.lda + C) * 2u; voffB[i] = (unsigned)(Rb * K + C) * 2u; }
    const size_t kstep = (size_t)(BK * 2);
    const size_t hstepA = (size_t)HALF * g.lda * 2, hstepB = (size_t)HALF * K * 2;
    const size_t tstepA = 2 * hstepA, tstepB = 2 * hstepB;
    const unsigned ldsw = (unsigned)wid * 1024u;
    const int aoff = lds_byte(wr * 64 + fr, fq * 8), boff = lds_byte(wc * 32 + fr, fq * 8);
#define PG8_SA(b, h) (((b) * 2 + (h)) * HTB)
#define PG8_SB(b, h) ((4 + (b) * 2 + (h)) * HTB)
#define PG8_STAGE(bufoff, gbase, voff) do { _Pragma("unroll") for (int _i = 0; _i < 2; ++_i) \
        __builtin_amdgcn_global_load_lds((const unsigned*)((const char*)(gbase) + (voff)[_i]), (LAS unsigned*)(lds + (bufoff) + ldsw + _i * 8192), 16, 0, 0); } while (0)
#define PG8_LDA(dst, b, h) do { _Pragma("unroll") for (int m = 0; m < 4; ++m) _Pragma("unroll") for (int k = 0; k < 2; ++k) dst[m][k] = *(const LAS bf16x8*)(lds + PG8_SA(b, h) + aoff + m * 2048 + k * 1024); } while (0)
#define PG8_LDB(dst, b, h) do { _Pragma("unroll") for (int n = 0; n < 2; ++n) _Pragma("unroll") for (int k = 0; k < 2; ++k) dst[n][k] = *(const LAS bf16x8*)(lds + PG8_SB(b, h) + boff + n * 2048 + k * 1024); } while (0)
#define PG8_MMA(ai, bj, At, Bt) do { __builtin_amdgcn_s_setprio(1); _Pragma("unroll") for (int m = 0; m < 4; ++m) _Pragma("unroll") for (int n = 0; n < 2; ++n) _Pragma("unroll") for (int k = 0; k < 2; ++k) \
        acc[ai][bj][m][n] = __builtin_amdgcn_mfma_f32_16x16x32_bf16(Bt[n][k], At[m][k], acc[ai][bj][m][n], 0, 0, 0); __builtin_amdgcn_s_setprio(0); } while (0)
#define PG8_WAIT_V(n) asm volatile("s_waitcnt vmcnt(" #n ")" ::: "memory")
#define PG8_WAIT_L(n) asm volatile("s_waitcnt lgkmcnt(" #n ")" ::: "memory")
#define PG8_BAR __builtin_amdgcn_s_barrier()
#define PG8_SCHED __builtin_amdgcn_sched_barrier(0)
    Unit cur, nxt; int ui = 0;
    if (!S.next(0, cur)) return;
    f32x4 acc[2][2][4][2];
#pragma unroll
    for (int a = 0; a < 2; ++a)
#pragma unroll
        for (int b = 0; b < 2; ++b)
#pragma unroll
            for (int m = 0; m < 4; ++m)
#pragma unroll
                for (int n = 0; n < 2; ++n) acc[a][b][m][n] = (f32x4){0.f, 0.f, 0.f, 0.f};
    bf16x8 At[4][2], B0[2][2], B1[2][2];
    const char* cAb = (const char*)g.A + (size_t)cur.pm * tstepA;
    const char* cB = (const char*)g.Bt + (size_t)cur.pn * tstepB;
    {
        const char* cA = cAb + AM.koff(0);
        PG8_STAGE(PG8_SB(0, 0), cB, voffB); PG8_STAGE(PG8_SA(0, 0), cA, voffA); PG8_STAGE(PG8_SB(0, 1), cB + hstepB, voffB); PG8_STAGE(PG8_SA(0, 1), cA + hstepA, voffA);
        if (wr == 1) PG8_BAR;
        PG8_WAIT_V(4); PG8_BAR;
        PG8_STAGE(PG8_SB(1, 0), cB + kstep, voffB); PG8_STAGE(PG8_SA(1, 0), cA + kstep, voffA); PG8_STAGE(PG8_SB(1, 1), cB + hstepB + kstep, voffB);
        PG8_WAIT_V(6); PG8_BAR;
    }
    for (;;) {
        const bool has_next = S.next(ui + 1, nxt);
        const char* nAb = has_next ? (const char*)g.A + (size_t)nxt.pm * tstepA : cAb; const char* nB = has_next ? (const char*)g.Bt + (size_t)nxt.pn * tstepB : cB;
        int t = 0;
#pragma unroll 1
        for (int sg = 0; sg < AMap::NSEG; ++sg) {
        const int te = AM.seg_end(sg, nt);
#pragma unroll 1
        for (; t < te; t += 2) {
            const bool last = (t == nt - 2);
            const char* a1 = cAb + AM.koff(t + 1);
            const char* a2 = last ? nAb + AM.koff(0) : cAb + AM.koff(t + 2); const char* b2 = last ? nB : cB + (size_t)(t + 2) * kstep;
            const char* a3 = a2 + kstep; const char* b3 = b2 + kstep;
            PG8_LDB(B0, 0, 0); PG8_SCHED; PG8_LDA(At, 0, 0); PG8_STAGE(PG8_SA(1, 1), a1 + hstepA, voffA);
            PG8_WAIT_L(8); PG8_BAR; PG8_WAIT_L(0); PG8_MMA(0, 0, At, B0); PG8_BAR; PG8_SCHED;
            PG8_LDB(B1, 0, 1); PG8_STAGE(PG8_SB(0, 0), b2, voffB);
            PG8_BAR; PG8_WAIT_L(0); PG8_MMA(0, 1, At, B1); PG8_BAR;
            PG8_LDA(At, 0, 1); PG8_STAGE(PG8_SA(0, 0), a2, voffA);
            PG8_BAR; PG8_WAIT_L(0); PG8_MMA(1, 0, At, B0); PG8_BAR; PG8_SCHED;
            PG8_STAGE(PG8_SB(0, 1), b2 + hstepB, voffB);
            PG8_WAIT_V(6); PG8_BAR; PG8_MMA(1, 1, At, B1); PG8_BAR;
            PG8_LDB(B0, 1, 0); PG8_SCHED; PG8_LDA(At, 1, 0); PG8_STAGE(PG8_SA(0, 1), a2 + hstepA, voffA);
            PG8_WAIT_L(8); PG8_BAR; PG8_WAIT_L(0); PG8_MMA(0, 0, At, B0); PG8_BAR; PG8_SCHED;
            PG8_LDB(B1, 1, 1); PG8_STAGE(PG8_SB(1, 0), b3, voffB);
            PG8_BAR; PG8_WAIT_L(0); PG8_MMA(0, 1, At, B1); PG8_BAR;
            PG8_LDA(At, 1, 1); PG8_STAGE(PG8_SA(1, 0), a3, voffA);
            PG8_BAR; PG8_WAIT_L(0); PG8_MMA(1, 0, At, B0); PG8_BAR; PG8_SCHED;
            PG8_STAGE(PG8_SB(1, 1), b3 + hstepB, voffB);
            PG8_WAIT_V(6); PG8_BAR; PG8_MMA(1, 1, At, B1); PG8_BAR;
        }
        if (AMap::NSEG > 1 && sg + 1 < AMap::NSEG) E.mid(acc, cur, sg, wr, wc, fr, fq);
        }
        if constexpr (!Epi::AFTER_DRAIN) E(acc, cur, wr, wc, fr, fq);
        if (!has_next) break;
#pragma unroll
        for (int a = 0; a < 2; ++a)
#pragma unroll
            for (int b = 0; b < 2; ++b)
#pragma unroll
                for (int m = 0; m < 4; ++m)
#pragma unroll
                    for (int n = 0; n < 2; ++n) acc[a][b][m][n] = (f32x4){0.f, 0.f, 0.f, 0.f};
        cur = nxt; cAb = nAb; cB = nB; ++ui;
    }
    PG8_WAIT_V(0);
    if (wr == 0) PG8_BAR;
    PG8_BAR;
    if constexpr (Epi::AFTER_DRAIN) E.fused(acc, cur, wr, wc, fr, fq, lds, wid, lane);
#undef PG8_SA
#undef PG8_SB
#undef PG8_STAGE
#undef PG8_LDA
#undef PG8_LDB
#undef PG8_MMA
#undef PG8_WAIT_V
#undef PG8_WAIT_L
#undef PG8_BAR
#undef PG8_SCHED
}
}
using pg8::cvt_pk_bf16;

struct EpiIn1 {
    static constexpr bool PERM = true, AFTER_DRAIN = false;
    bf16_t* PA; bf16_t* HB; const float* CS;
    __device__ __forceinline__ void mid(f32x4 (&)[2][2][4][2], const pg8::Unit&, int, int, int, int, int) const {}
    __device__ __forceinline__ void operator()(const f32x4 (&acc)[2][2][4][2], const pg8::Unit& u, int wr, int wc, int fr, int fq) const {
        int row0 = u.pm * 256 + wr * 64 + fr; asm volatile("" : "+v"(row0));
        if (u.pn < 4) {
            const int dl = 16 * wc + 4 * fq; const float qs = u.pn < 2 ? 0.08838834764831845f : 1.0f;
#pragma unroll
            for (int ai = 0; ai < 2; ++ai)
#pragma unroll
                for (int m = 0; m < 4; ++m) { const int row = row0 + ai * 128 + m * 16; bf16_t* rowp = PA + (size_t)row * NA + u.pn * 256 + dl;
                    const f32x4* cp = (const f32x4*)(CS + ((size_t)row * 64 + dl) * 2); const f32x4 c01 = cp[0], c23 = cp[1];
                    const float cs_[4] = {c01[0], c01[2], c23[0], c23[2]}, sn_[4] = {c01[1], c01[3], c23[1], c23[3]};
#pragma unroll
                    for (int bj = 0; bj < 2; ++bj) { const f32x4 x1 = acc[ai][bj][m][0], x2 = acc[ai][bj][m][1]; float o1[4], o2[4];
#pragma unroll
                        for (int j = 0; j < 4; ++j) { o1[j] = (x1[j] * cs_[j] - x2[j] * sn_[j]) * qs; o2[j] = (x1[j] * sn_[j] + x2[j] * cs_[j]) * qs; }
                        u32x2 w1, w2; w1.x = cvt_pk_bf16(o1[0], o1[1]); w1.y = cvt_pk_bf16(o1[2], o1[3]); w2.x = cvt_pk_bf16(o2[0], o2[1]); w2.y = cvt_pk_bf16(o2[2], o2[3]);
                        *(u32x2*)(rowp + bj * 128) = w1; *(u32x2*)(rowp + bj * 128 + 64) = w2; } }
        } else if (u.pn < 18) {
            const int col0 = u.pn * 256 + wc * 32 + 8 * fq;
#if MK_SC1
            const __amdgpu_buffer_rsrc_t rsrc = __builtin_amdgcn_make_buffer_rsrc((void*)PA, (short)0, (int)((size_t)T * NA * 2), 0x00020000);
#endif
#pragma unroll
            for (int ai = 0; ai < 2; ++ai)
#pragma unroll
                for (int m = 0; m < 4; ++m) { bf16_t* rowp = PA + (size_t)(row0 + ai * 128 + m * 16) * NA + col0;
#pragma unroll
                    for (int bj = 0; bj < 2; ++bj) { const f32x4 v0 = acc[ai][bj][m][0], v1 = acc[ai][bj][m][1];
                        u32x4 w; w.x = cvt_pk_bf16(v0[0], v0[1]); w.y = cvt_pk_bf16(v0[2], v0[3]); w.z = cvt_pk_bf16(v1[0], v1[1]); w.w = cvt_pk_bf16(v1[2], v1[3]);
#if MK_SC1
                        __builtin_amdgcn_raw_buffer_store_b128(w, rsrc, (int)(((size_t)(row0 + ai * 128 + m * 16) * NA + col0 + bj * 128) * 2), 0, 16);
#else
                        *(u32x4*)(rowp + bj * 128) = w;
#endif
                        if (m == 3 && u.pn >= 12 && wr == 1 && fr >= 13) {
                            const int row = row0 + ai * 128 + 48; *(u32x4*)(HB + ((size_t)(row >> 7) * 3 + (fr - 13)) * 1536 + (col0 - PA_XBC) + bj * 128) = w; } } }
        } else {
            const int ch0 = 64 * (u.pn - 18) + 16 * wc + 4 * fq;
#pragma unroll
            for (int ai = 0; ai < 2; ++ai)
#pragma unroll
                for (int m = 0; m < 4; ++m) { bf16_t* rowp = PA + (size_t)(row0 + ai * 128 + m * 16) * NA;
                    const f32x4 bg = acc[ai][0][m][0], cg = acc[ai][0][m][1], hv = acc[ai][1][m][0], gt = acc[ai][1][m][1];
                    f32x4 uu = cg * hv, ww;
#pragma unroll
                    for (int j = 0; j < 4; ++j) ww[j] = bg[j] * silu_f(gt[j]);
                    u32x2 pu, pw; pu.x = cvt_pk_bf16(uu[0], uu[1]); pu.y = cvt_pk_bf16(uu[2], uu[3]); pw.x = cvt_pk_bf16(ww[0], ww[1]); pw.y = cvt_pk_bf16(ww[2], ww[3]);
                    *(u32x2*)(rowp + PA_U + ch0) = pu; *(u32x2*)(rowp + PA_W + ch0) = pw; }
        }
    }
};
__device__ __forceinline__ int lg_col(int gate, int c) {
    return gate == 0 ? c : (gate == 1 ? PA_XBC + c : (c < 512 ? PA_V + c : PA_XBC + 1024 + (c - 512)));
}
struct EpiIn2 {
    static constexpr bool PERM = true, AFTER_DRAIN = false;
    bf16_t* PA; const float* SSQ;
    __device__ __forceinline__ void mid(f32x4 (&)[2][2][4][2], const pg8::Unit&, int, int, int, int, int) const {}
    __device__ __forceinline__ void operator()(const f32x4 (&acc)[2][2][4][2], const pg8::Unit& u, int wr, int wc, int fr, int fq) const {
        int row0 = u.pm * 256 + wr * 64 + fr; asm volatile("" : "+v"(row0));
        const int gate = u.pn >> 2, cbase = (u.pn & 3) * 256;
        const __amdgpu_buffer_rsrc_t rsrc = __builtin_amdgcn_make_buffer_rsrc((void*)PA, (short)0, (int)((size_t)T * NA * 2), 0x00020000);
#pragma unroll
        for (int ai = 0; ai < 2; ++ai)
#pragma unroll
            for (int m = 0; m < 4; ++m) { const int row = row0 + ai * 128 + m * 16; bf16_t* rowp = PA + (size_t)row * NA;
                float rinv = 1.0f;
                if (gate == 1) { const f32x2 q = *(const f32x2*)(SSQ + (size_t)row * 2); rinv = sqrtf((q[0] + q[1]) * (1.0f / 1024.0f) + EPS); }
#pragma unroll
                for (int bj = 0; bj < 2; ++bj) { f32x4 v0 = acc[ai][bj][m][0], v1 = acc[ai][bj][m][1];
#pragma unroll
                    for (int j = 0; j < 4; ++j) { v0[j] = (1.0f + __expf(-fminf(fmaxf(v0[j], -30.f), 30.f))) * rinv; v1[j] = (1.0f + __expf(-fminf(fmaxf(v1[j], -30.f), 30.f))) * rinv; }
                    u32x4 w; w.x = cvt_pk_bf16(v0[0], v0[1]); w.y = cvt_pk_bf16(v0[2], v0[3]); w.z = cvt_pk_bf16(v1[0], v1[1]); w.w = cvt_pk_bf16(v1[2], v1[3]);
                    const int c = cbase + bj * 128 + wc * 32 + 8 * fq;
                    __builtin_amdgcn_raw_buffer_store_b128(w, rsrc, (int)(((size_t)row * NA + lg_col(gate, c)) * 2), 0, 16); } }
    }
};
struct EpiMerge {
    static constexpr bool PERM = true, AFTER_DRAIN = false;
    const bf16_t* PA; bf16_t* MG;
    __device__ __forceinline__ void scale8(f32x4& v0, f32x4& v1, const u32x4 nn, const u32x4 dn) const {
#pragma unroll
        for (int j = 0; j < 4; ++j) { v0[j] *= bfe(nn, j) * __builtin_amdgcn_rcpf(bfe(dn, j)); v1[j] *= bfe(nn, 4 + j) * __builtin_amdgcn_rcpf(bfe(dn, 4 + j)); }
    }
    __device__ __forceinline__ void mid(f32x4 (&acc)[2][2][4][2], const pg8::Unit& u, int sg, int wr, int wc, int fr, int fq) const {
        int row0 = u.pm * 256 + wr * 64 + fr; asm volatile("" : "+v"(row0));
        const int c0 = u.pn * 256 + wc * 32 + 8 * fq;
        const int ncol = sg == 0 ? lg_col(0, c0) : lg_col(2, c0), dcol = sg == 0 ? lg_col(1, c0) : lg_col(0, c0);
#pragma unroll
        for (int ai = 0; ai < 2; ++ai) {
            u32x4 nn[4][2], dn[4][2];
#pragma unroll
            for (int m = 0; m < 4; ++m) { const bf16_t* rowp = PA + (size_t)(row0 + ai * 128 + m * 16) * NA;
#pragma unroll
                for (int bj = 0; bj < 2; ++bj) { nn[m][bj] = *(const u32x4*)(rowp + ncol + bj * 128); dn[m][bj] = *(const u32x4*)(rowp + dcol + bj * 128); } }
#pragma unroll
            for (int m = 0; m < 4; ++m)
#pragma unroll
                for (int bj = 0; bj < 2; ++bj) scale8(acc[ai][bj][m][0], acc[ai][bj][m][1], nn[m][bj], dn[m][bj]);
            asm volatile("" ::: "memory"); }
    }
    __device__ __forceinline__ void operator()(const f32x4 (&acc)[2][2][4][2], const pg8::Unit& u, int wr, int wc, int fr, int fq) const {
        int row0 = u.pm * 256 + wr * 64 + fr; asm volatile("" : "+v"(row0));
        const int c0 = u.pn * 256 + wc * 32 + 8 * fq, dcol = lg_col(2, c0);
        const __amdgpu_buffer_rsrc_t rsrc = __builtin_amdgcn_make_buffer_rsrc((void*)MG, (short)0, (int)((size_t)T * 1024 * 2), 0x00020000);
#pragma unroll
        for (int ai = 0; ai < 2; ++ai) {
            u32x4 dn[4][2];
#pragma unroll
            for (int m = 0; m < 4; ++m)
#pragma unroll
                for (int bj = 0; bj < 2; ++bj) dn[m][bj] = *(const u32x4*)(PA + (size_t)(row0 + ai * 128 + m * 16) * NA + dcol + bj * 128);
#pragma unroll
            for (int m = 0; m < 4; ++m)
#pragma unroll
                for (int bj = 0; bj < 2; ++bj) { f32x4 v0 = acc[ai][bj][m][0], v1 = acc[ai][bj][m][1];
#pragma unroll
                    for (int j = 0; j < 4; ++j) { v0[j] *= __builtin_amdgcn_rcpf(bfe(dn[m][bj], j)); v1[j] *= __builtin_amdgcn_rcpf(bfe(dn[m][bj], 4 + j)); }
                    u32x4 w; w.x = cvt_pk_bf16(v0[0], v0[1]); w.y = cvt_pk_bf16(v0[2], v0[3]); w.z = cvt_pk_bf16(v1[0], v1[1]); w.w = cvt_pk_bf16(v1[2], v1[3]);
                    __builtin_amdgcn_raw_buffer_store_b128(w, rsrc, (int)(((size_t)(row0 + ai * 128 + m * 16) * 1024 + c0 + bj * 128) * 2), 0, 16); }
            asm volatile("" ::: "memory"); }
    }
};
struct EpiOut {
    static constexpr bool PERM = false, AFTER_DRAIN = false;
    const float* xin; float* xout; const float* rgate;
    __device__ __forceinline__ void mid(f32x4 (&)[2][2][4][2], const pg8::Unit&, int, int, int, int, int) const {}
    __device__ __forceinline__ void operator()(const f32x4 (&acc)[2][2][4][2], const pg8::Unit& u, int wr, int wc, int fr, int fq) const {
        int row0 = u.pm * 256 + wr * 64 + fr, col0 = u.pn * 256 + wc * 32 + 4 * fq; asm volatile("" : "+v"(row0), "+v"(col0));
        const float* rg = rgate + (size_t)(u.pm / 8) * 3072 + col0;
        const __amdgpu_buffer_rsrc_t rsrc = __builtin_amdgcn_make_buffer_rsrc((void*)xout, (short)0, (int)((size_t)T * D * 4), 0x00020000);
        f32x4 gv[2][2];
#pragma unroll
        for (int bj = 0; bj < 2; ++bj)
#pragma unroll
            for (int n = 0; n < 2; ++n) gv[bj][n] = *(const f32x4*)(rg + bj * 128 + n * 16);
#pragma unroll
        for (int ai = 0; ai < 2; ++ai) {
            f32x4 xv[4][2][2];
#pragma unroll
            for (int m = 0; m < 4; ++m)
#pragma unroll
                for (int bj = 0; bj < 2; ++bj)
#pragma unroll
                    for (int n = 0; n < 2; ++n) xv[m][bj][n] = __builtin_nontemporal_load((const f32x4*)(xin + (size_t)(row0 + ai * 128 + m * 16) * D + col0 + bj * 128 + n * 16));
#pragma unroll
            for (int m = 0; m < 4; ++m)
#pragma unroll
                for (int bj = 0; bj < 2; ++bj)
#pragma unroll
                    for (int n = 0; n < 2; ++n) { const f32x4 o = xv[m][bj][n] + gv[bj][n] * acc[ai][bj][m][n];
                        __builtin_amdgcn_raw_buffer_store_b128(__builtin_bit_cast(u32x4, o), rsrc, (int)(((size_t)(row0 + ai * 128 + m * 16) * D + col0 + bj * 128 + n * 16) * 4), 0, 16); }
            asm volatile("" ::: "memory"); }
    }
};

constexpr int CW_X = 32768;
struct EpiOutFinal {
    static constexpr bool PERM = false, AFTER_DRAIN = true;
    const float* xin; float* xout; const float* rgate; const float* gfin; unsigned* ctl;
    __device__ __forceinline__ void mid(f32x4 (&)[2][2][4][2], const pg8::Unit&, int, int, int, int, int) const {}
    __device__ __forceinline__ void fused(f32x4 (&acc)[2][2][4][2], const pg8::Unit& u, int wr, int wc, int fr, int fq, LAS unsigned char* lds, int wid, int lane) const {
        int row0 = u.pm * 256 + wr * 64 + fr, col0 = u.pn * 256 + wc * 32 + 4 * fq; asm volatile("" : "+v"(row0), "+v"(col0));
        LAS float* P = (LAS float*)lds; LAS float* S = (LAS float*)(lds + 8192);
        const __amdgpu_buffer_rsrc_t rin = __builtin_amdgcn_make_buffer_rsrc((void*)xin, (short)0, (int)((size_t)T * D * 4), 0x00020000);
        { const float* rg = rgate + (size_t)(u.pm / 8) * 3072 + col0;
          f32x4 gv[2][2];
#pragma unroll
          for (int bj = 0; bj < 2; ++bj)
#pragma unroll
              for (int n = 0; n < 2; ++n) gv[bj][n] = *(const f32x4*)(rg + bj * 128 + n * 16);
#pragma unroll
          for (int ai = 0; ai < 2; ++ai)
#pragma unroll
            for (int mh = 0; mh < 2; ++mh) { f32x4 xv[2][2][2];
#pragma unroll
              for (int mm = 0; mm < 2; ++mm)
#pragma unroll
                  for (int bj = 0; bj < 2; ++bj)
#pragma unroll
                      for (int n = 0; n < 2; ++n) xv[mm][bj][n] = __builtin_bit_cast(f32x4, __builtin_amdgcn_raw_buffer_load_b128(rin, ((row0 + ai * 128 + (2 * mh + mm) * 16) * D + col0 + bj * 128 + n * 16) * 4, 0, 2));
#pragma unroll
              for (int mm = 0; mm < 2; ++mm)
#pragma unroll
                  for (int bj = 0; bj < 2; ++bj)
#pragma unroll
                      for (int n = 0; n < 2; ++n) acc[ai][bj][2 * mh + mm][n] = xv[mm][bj][n] + gv[bj][n] * acc[ai][bj][2 * mh + mm][n];
#pragma unroll
              for (int mm = 0; mm < 2; ++mm)
                  asm volatile("" : "+v"(acc[ai][0][2 * mh + mm][0]), "+v"(acc[ai][0][2 * mh + mm][1]), "+v"(acc[ai][1][2 * mh + mm][0]), "+v"(acc[ai][1][2 * mh + mm][1]));
              asm volatile("" ::: "memory"); } }
#pragma unroll
        for (int ai = 0; ai < 2; ++ai)
#pragma unroll
            for (int m = 0; m < 4; ++m) { float q = 0.f;
#pragma unroll
                for (int bj = 0; bj < 2; ++bj)
#pragma unroll
                    for (int n = 0; n < 2; ++n) { const f32x4 x = acc[ai][bj][m][n]; q += (x[0] * x[0] + x[1] * x[1]) + (x[2] * x[2] + x[3] * x[3]); }
                q += xor16(q); q += xor32(q, lane);
                if (fq == 0) P[(ai * 128 + wr * 64 + m * 16 + fr) * 4 + wc] = q; }
        asm volatile("s_waitcnt lgkmcnt(0)" ::: "memory"); __builtin_amdgcn_s_barrier(); asm volatile("" ::: "memory");
        unsigned* cnt = ctl + CW_SEAM + 2 * 4096 + 64 * u.pm; const int prow = wid * 64 + lane;
        if (wid < 4) { const f32x4 p4 = *(const LAS f32x4*)(P + prow * 4);
            __hip_atomic_store((float*)(ctl + CW_X) + ((size_t)(u.pm * 256 + prow) * 4 + u.pn), (p4[0] + p4[1]) + (p4[2] + p4[3]), __ATOMIC_RELAXED, __HIP_MEMORY_SCOPE_AGENT);
            asm volatile("s_waitcnt vmcnt(0)" ::: "memory");
            if (lane == 0) __hip_atomic_fetch_add(cnt, 1u, __ATOMIC_RELAXED, __HIP_MEMORY_SCOPE_AGENT); }
        if (wid == 0) { unsigned sp = 0;
            while ((unsigned)__builtin_amdgcn_readfirstlane(__hip_atomic_load(cnt, __ATOMIC_RELAXED, __HIP_MEMORY_SCOPE_AGENT)) < 16u) { __builtin_amdgcn_s_sleep(2); if (++sp > (1u << 22)) break; }
            __builtin_amdgcn_fence(__ATOMIC_ACQUIRE, "agent"); }
        asm volatile("s_waitcnt vmcnt(0) lgkmcnt(0)" ::: "memory"); __builtin_amdgcn_s_barrier(); asm volatile("" ::: "memory");
        if (wid < 4) { const float* sl = (const float*)(ctl + CW_X) + (size_t)(u.pm * 256 + prow) * 4; float t = 0.f;
#pragma unroll
            for (int k = 0; k < 4; ++k) t += __hip_atomic_load(sl + k, __ATOMIC_RELAXED, __HIP_MEMORY_SCOPE_AGENT);
            S[prow] = 1.0f / sqrtf(t * (1.0f / D) + EPS); }
        asm volatile("s_waitcnt vmcnt(0) lgkmcnt(0)" ::: "memory"); __builtin_amdgcn_s_barrier(); asm volatile("" ::: "memory");
        asm volatile("" : "+v"(row0), "+v"(col0));
        const __amdgpu_buffer_rsrc_t rsrc = __builtin_amdgcn_make_buffer_rsrc((void*)xout, (short)0, (int)((size_t)T * D * 4), 0x00020000);
        f32x4 gf[2][2];
#pragma unroll
        for (int bj = 0; bj < 2; ++bj)
#pragma unroll
            for (int n = 0; n < 2; ++n) gf[bj][n] = *(const f32x4*)(gfin + col0 + bj * 128 + n * 16);
#pragma unroll
        for (int ai = 0; ai < 2; ++ai)
#pragma unroll
            for (int m = 0; m < 4; ++m) { const float rs = S[ai * 128 + wr * 64 + m * 16 + fr];
#pragma unroll
                for (int bj = 0; bj < 2; ++bj)
#pragma unroll
                    for (int n = 0; n < 2; ++n) { const f32x4 o = (acc[ai][bj][m][n] * rs) * gf[bj][n];
                        __builtin_amdgcn_raw_buffer_store_b128(__builtin_bit_cast(u32x4, o), rsrc, ((row0 + ai * 128 + m * 16) * D + col0 + bj * 128 + n * 16) * 4, 0, 16); } }
    }
};

struct KArgs { const void* in[19]; float* out; unsigned char* ws; int ph_lo, ph_hi, rep_ph, rep_n, sub, pad; };
constexpr int ARGS_OFF = RING_BYTES + 512;
enum { I_X = 0, I_C, I_POS, I_NORM_G, I_W_ADA, I_B_ADA, I_W_IN, I_CONV_W, I_CONV_B, I_DT_BIAS, I_A_LOG, I_SSM_D, I_SSM_NORM_G, I_SC_CONV_W, I_W_BR_RET, I_W_BR_SSM, I_W_BR_SC, I_W_OUT, I_FINAL_G };
struct Args { LAS unsigned char* lds; float* out; unsigned char* ws;
    __device__ __forceinline__ const float* f(int i) const { const LAS unsigned* p = (const LAS unsigned*)(lds + ARGS_OFF) + 2 * i;
        const unsigned lo = __builtin_amdgcn_readfirstlane(p[0]), hi = __builtin_amdgcn_readfirstlane(p[1]); return (const float*)(((unsigned long long)hi << 32) | lo); }
};
#define ARGF(name, idx) const float* const name = a.f(idx)

__device__ __forceinline__ int win_srccol(int n) {
    if (n < 1024) { const int p = n & 255, bj = p >> 7, wc = (p >> 5) & 3, fq = (p >> 3) & 3, nn = (p >> 2) & 1, e = p & 3;
        return (n & ~255) + 128 * bj + 64 * nn + 16 * wc + 4 * fq + e; }
    if (n < 4608) return n;
    if (n < N1A) { const int p = (n - 4608) & 255, tt = (n - 4608) >> 8; const int bj = p >> 7, wc = (p >> 5) & 3, fq = (p >> 3) & 3, nn = (p >> 2) & 1, e = p & 3;
        const int q = 2 * bj + nn, ch = 64 * tt + 16 * wc + 4 * fq + e; return C_CB + 512 * q + ch; }
    return C_MG + (n - N1A);
}
struct WItem { const float* src; const float* scale; bf16_t* dst; int ldsrc, k0, nsrc, ldd, dk0, n0; };
__device__ __forceinline__ WItem witem(const Args a, int l, int it, int lane) {
    constexpr int I_IN = (NW1 / 32) * 16, I_BR = 32 * 32;
    WItem w; w.scale = nullptr;
    bf16_t* WinT = (bf16_t*)(a.ws + WS_WIN); bf16_t* WbrT = (bf16_t*)(a.ws + WS_WBR); bf16_t* WoutT = (bf16_t*)(a.ws + WS_WOUT);
    if (it < I_IN) { const int nb = it / 16, kb = it % 16; w.src = a.f(I_W_IN) + (size_t)l * 1024 * IN_W; w.ldsrc = IN_W; w.k0 = 64 * kb; w.nsrc = win_srccol(32 * nb + (lane & 31)); w.dst = WinT; w.ldd = 1024; w.dk0 = 64 * kb; w.n0 = 32 * nb; return w; }
    it -= I_IN;
    if (it < I_BR) { const int nb = it / 32, kb = it % 32; w.ldsrc = 1024; w.nsrc = 32 * nb + (lane & 31); w.dst = WbrT; w.ldd = 2048; w.dk0 = 64 * kb; w.n0 = 32 * nb;
        if (kb < 16) { w.src = a.f(I_W_BR_SSM) + (size_t)l * 1024 * 1024; w.k0 = 64 * kb; w.scale = a.f(I_SSM_NORM_G) + l * 1024; }
        else if (kb < 24) { w.src = a.f(I_W_BR_RET) + (size_t)l * 512 * 1024; w.k0 = 64 * (kb - 16); }
        else { w.src = a.f(I_W_BR_SC) + (size_t)l * 512 * 1024; w.k0 = 64 * (kb - 24); }
        return w; }
    it -= I_BR;
    { const int nb = it / 16, kb = it % 16; w.src = a.f(I_W_OUT) + (size_t)l * 1024 * 1024; w.ldsrc = 1024; w.k0 = 64 * kb; w.nsrc = 32 * nb + (lane & 31); w.dst = WoutT; w.ldd = 1024; w.dk0 = 64 * kb; w.n0 = 32 * nb; }
    return w;
}
__device__ __forceinline__ void wload(const WItem& w, int lane, float (&v)[32]) {
#pragma unroll
    for (int i = 0; i < 32; ++i) { const int kk = 2 * i + (lane >> 5); float x = w.nsrc < 0 ? 0.f : w.src[(size_t)(w.k0 + kk) * w.ldsrc + w.nsrc]; if (w.scale) x *= w.scale[w.k0 + kk]; v[i] = x; }
}
__device__ __forceinline__ void wstore(const WItem& w, int lane, const float (&v)[32], LAS float* scr) {
#pragma unroll
    for (int i = 0; i < 32; ++i) scr[(2 * i + (lane >> 5)) * 33 + (lane & 31)] = v[i];
    LDS_WAIT(); asm volatile("" ::: "memory");
    const int c = lane & 7;
#pragma unroll
    for (int j = 0; j < 4; ++j) { const int n = (lane >> 3) + 8 * j; const LAS float* s = scr + (8 * c) * 33 + n;
        u32x4 o; o.x = pk2(s[0 * 33], s[1 * 33]); o.y = pk2(s[2 * 33], s[3 * 33]); o.z = pk2(s[4 * 33], s[5 * 33]); o.w = pk2(s[6 * 33], s[7 * 33]);
        *(u32x4*)(w.dst + (size_t)(w.n0 + n) * w.ldd + w.dk0 + 8 * c) = o; }
    LDS_WAIT(); asm volatile("" ::: "memory");
}
__device__ __attribute__((noinline)) void convert_weights(const Args a, int l, LAS unsigned char* lds, int gw, int NGW, int wave, int lane) {
    l = __builtin_amdgcn_readfirstlane(l); gw = __builtin_amdgcn_readfirstlane(gw); NGW = __builtin_amdgcn_readfirstlane(NGW); wave = __builtin_amdgcn_readfirstlane(wave);
    LAS float* scr = (LAS float*)(lds + wave * 16384);
    constexpr int NIT = (NW1 / 32) * 16 + 32 * 32 + 32 * 16;
    if (gw >= NIT) return;
    float v[32]; WItem cur = witem(a, l, gw, lane); wload(cur, lane, v);
#pragma unroll 1
    for (int it = gw; it < NIT; it += NGW) {
        const bool more = it + NGW < NIT;
        float nv[32]; WItem nxt = cur;
        if (more) { nxt = witem(a, l, it + NGW, lane); wload(nxt, lane, nv); }
        wstore(cur, lane, v, scr);
        if (more) { cur = nxt;
#pragma unroll
            for (int i = 0; i < 32; ++i) v[i] = nv[i]; }
    }
}

__device__ __attribute__((noinline)) void phase_p0(const Args a, LAS unsigned char* lds, int bid, int nblk, int tid, int wave, int lane) {
    float* ada = (float*)(a.ws + WS_ADA);
    LAS float* scs = (LAS float*)lds;
    LAS float* red = (LAS float*)(lds + 32768);
    for (int i = tid; i < 8 * 1024; i += 512) scs[i] = silu_f(a.f(I_C)[i]);
    __syncthreads();
    for (int item = bid; item < 256; item += nblk) {
        const int l = item >> 7, j0 = 24 * (item & 127);
        if (tid < 504) { const int jl = tid % 24, kg = tid / 24; float acc[8];
#pragma unroll
            for (int b = 0; b < 8; ++b) acc[b] = 0.f;
            const float* w = a.f(I_W_ADA) + (size_t)l * 1024 * 3072 + j0 + jl;
            for (int k = kg; k < 1024; k += 21) { const float wv = w[(size_t)k * 3072];
#pragma unroll
                for (int b = 0; b < 8; ++b) acc[b] += scs[b * 1024 + k] * wv; }
#pragma unroll
            for (int b = 0; b < 8; ++b) red[(kg * 24 + jl) * 8 + b] = acc[b]; }
        __syncthreads();
        if (tid < 192) { const int jl = tid >> 3, b = tid & 7; float s = 0.f;
            for (int kg = 0; kg < 21; ++kg) s += red[(kg * 24 + jl) * 8 + b];
            ada[((size_t)l * 8 + b) * 3072 + j0 + jl] = s + a.f(I_B_ADA)[l * 3072 + j0 + jl]; }
        __syncthreads();
    }
    float* cs = (float*)(a.ws + WS_CS);
    for (int idx = bid * 512 + tid; idx < T * 64; idx += nblk * 512) { const int t = idx >> 6, i = idx & 63;
        const float inv_freq = powf(10000.0f, -(float)(2 * i) / 128.0f); const float ang = (float)((const int*)a.f(I_POS))[t] * inv_freq;
        cs[2 * (size_t)idx] = cosf(ang); cs[2 * (size_t)idx + 1] = sinf(ang); }
    { bf16_t* WdtT = (bf16_t*)(a.ws + WS_WDT); const float* w_in = a.f(I_W_IN);
      for (int idx = bid * 512 + tid; idx < 2 * 16 * 1024; idx += nblk * 512) { const int ll = idx >> 14, j = (idx >> 10) & 15, k = idx & 1023;
          WdtT[idx] = (bf16_t)f2bf(w_in[((size_t)ll * 1024 + k) * IN_W + C_DT + j]); } }
}

__device__ __attribute__((noinline)) void phase_hprep(const Args a, int l, const float* xcur, LAS unsigned char* lds, int bid, int nblk, int tid, int wave, int lane) {
    const float* ada = (const float*)(a.ws + WS_ADA) + (size_t)l * 8 * 3072;
    bf16_t* H = (bf16_t*)(a.ws + WS_H);
    const float* ng = a.f(I_NORM_G) + l * 1024;
    const int gw = bid * 8 + wave, NGW = nblk * 8;
    const bf16_t* WdtT = (const bf16_t*)(a.ws + WS_WDT) + (size_t)l * 16 * 1024; float* DT = (float*)(a.ws + WS_DT);
    const int fr = lane & 15, fq = lane >> 4;
    const float dtb = a.f(I_DT_BIAS)[l * 16 + fr];
    for (int base = gw * 8; base < T; base += NGW * 8) {
#pragma unroll
        for (int hf = 0; hf < 2; ++hf) {
            f32x4 v[4][4];
#pragma unroll
            for (int u = 0; u < 4; ++u) { const f32x4* xr = (const f32x4*)(xcur + (size_t)(base + 4 * hf + u) * D) + lane;
#pragma unroll
                for (int j = 0; j < 4; ++j) v[u][j] = xr[64 * j]; }
#pragma unroll
            for (int u = 0; u < 4; ++u) { const int tok = base + 4 * hf + u; const int b = tok >> 11; float s = 0.f;
#pragma unroll
                for (int j = 0; j < 4; ++j) s += (v[u][j][0] * v[u][j][0] + v[u][j][1] * v[u][j][1]) + (v[u][j][2] * v[u][j][2] + v[u][j][3] * v[u][j][3]);
                const float rstd = 1.0f / sqrtf(wave_sum(s) * (1.0f / D) + EPS);
                const float* shift = ada + (size_t)b * 3072; const float* scale = shift + 1024;
                unsigned long long* o8 = (unsigned long long*)(H + (size_t)tok * D) + lane;
#pragma unroll
                for (int j = 0; j < 4; ++j) { const int c = 4 * lane + 256 * j;
                    const f32x4 g = *(const f32x4*)(ng + c), sc = *(const f32x4*)(scale + c), sh = *(const f32x4*)(shift + c);
                    const f32x4 hv = (v[u][j] * rstd) * g * (sc + 1.0f) + sh;
                    o8[64 * j] = (unsigned long long)pk2(hv[0], hv[1]) | ((unsigned long long)pk2(hv[2], hv[3]) << 32); } }
        }
        VM_WAIT();
        { f32x4 acc = (f32x4){0.f, 0.f, 0.f, 0.f};
          const bf16_t* hp = H + (size_t)(base + (fr & 7)) * D + 8 * fq; const bf16_t* wp = WdtT + fr * 1024 + 8 * fq;
#pragma unroll 8
          for (int ks = 0; ks < 32; ++ks) acc = __builtin_amdgcn_mfma_f32_16x16x32_bf16(__builtin_bit_cast(bf16x8, *(const u32x4*)(hp + 32 * ks)), __builtin_bit_cast(bf16x8, *(const u32x4*)(wp + 32 * ks)), acc, 0, 0, 0);
          if (fq < 2) {
#pragma unroll
              for (int r = 0; r < 4; ++r) { const float xv = acc[r] + dtb; DT[(size_t)(base + 4 * fq + r) * 16 + fr] = xv > 20.f ? xv : log1pf(__expf(xv)); } } }
    }
}

__device__ __attribute__((noinline)) void sc_items(const Args a, int l, int vb, int nvb, int tid, int dry) {
    dry = __builtin_amdgcn_readfirstlane(dry);
    bf16_t* PA = (bf16_t*)(a.ws + WS_PA); const float* cw = a.f(I_SC_CONV_W) + (size_t)l * 3 * 512;
    for (int idx0 = vb * 512 + tid; idx0 < T * 64; idx0 += 4 * nvb * 512) {
        u32x4 u2[4], u1[4], u0[4], wv[4];
#pragma unroll
        for (int q = 0; q < 4; ++q) { const int idx = idx0 + q * nvb * 512 < T * 64 ? idx0 + q * nvb * 512 : idx0; const int row = idx >> 6, c0 = (idx & 63) * 8, tl = row & (SEQ - 1);
            const bf16_t* rp = PA + (size_t)row * NA;
            u2[q] = *(const u32x4*)(rp + PA_U + c0); u1[q] = (u32x4){0u, 0u, 0u, 0u}; u0[q] = u1[q];
            if (tl >= 1) u1[q] = *(const u32x4*)(rp - NA + PA_U + c0);
            if (tl >= 2) u0[q] = *(const u32x4*)(rp - 2 * NA + PA_U + c0);
            wv[q] = *(const u32x4*)(rp + PA_W + c0); }
#pragma unroll
        for (int q = 0; q < 4; ++q) { const int idx = idx0 + q * nvb * 512; if (idx >= T * 64) break; const int row = idx >> 6, c0 = (idx & 63) * 8;
            float o[8];
#pragma unroll
            for (int j = 0; j < 4; ++j) { const int ca = c0 + 2 * j, cbb = ca + 1;
                o[2 * j] = bflo(wv[q][j]) * (cw[ca] * bflo(u0[q][j]) + cw[512 + ca] * bflo(u1[q][j]) + cw[1024 + ca] * bflo(u2[q][j]));
                o[2 * j + 1] = bfhi(wv[q][j]) * (cw[cbb] * bfhi(u0[q][j]) + cw[512 + cbb] * bfhi(u1[q][j]) + cw[1024 + cbb] * bfhi(u2[q][j])); }
            u32x4 r; r.x = pk2(o[0], o[1]); r.y = pk2(o[2], o[3]); r.z = pk2(o[4], o[5]); r.w = pk2(o[6], o[7]);
            if (!dry) *(u32x4*)(PA + (size_t)row * NA + PA_W + c0) = r; }
    }
}
typedef short bf16x4 __attribute__((ext_vector_type(4)));
constexpr int LDP = 136;
__device__ __forceinline__ f32x4 mfma16(bf16x8 a, bf16x8 b, f32x4 c) { return __builtin_amdgcn_mfma_f32_16x16x32_bf16(a, b, c, 0, 0, 0); }
__device__ __forceinline__ bf16x8 as_frag(u32x4 v) { return __builtin_bit_cast(bf16x8, v); }

typedef short s16x4 __attribute__((ext_vector_type(4)));
__device__ __forceinline__ bf16x8 frag_tr2(const LAS bf16_t* base, int pitch, int R, int R2, int C, int lane) {
    const int i = lane & 15, off = (i >> 2) * pitch + C + 4 * (i & 3);
    const s16x4 lo = __builtin_amdgcn_ds_read_tr16_b64_v4i16((LAS s16x4*)(base + R * pitch + off));
    const s16x4 hi = __builtin_amdgcn_ds_read_tr16_b64_v4i16((LAS s16x4*)(base + R2 * pitch + off));
    return (bf16x8){lo[0], lo[1], lo[2], lo[3], hi[0], hi[1], hi[2], hi[3]};
}
__device__ __forceinline__ void ret_stage_vn(const bf16_t* PA, size_t row0, int h, LAS bf16_t* Vn, int tid) {
#pragma unroll
    for (int r = 0; r < 4; ++r) { const int idx = tid + 512 * r, tok = idx >> 4, c = idx & 15;
        *(LAS u32x4*)(Vn + tok * LDP + 8 * c) = *(const u32x4*)(PA + (row0 + tok) * NA + PA_V + 128 * h + 8 * c); }
}
__device__ __forceinline__ void ret_stage_vt(const bf16_t* PA, size_t row0, int h, LAS bf16_t* Vt, int wave, int lane) {
    const size_t rowA = row0 + 2 * lane;
#pragma unroll
    for (int r = 0; r < 2; ++r) { const int c0 = 8 * (wave + 8 * r);
        const u32x4 va = *(const u32x4*)(PA + rowA * NA + PA_V + 128 * h + c0), vb = *(const u32x4*)(PA + (rowA + 1) * NA + PA_V + 128 * h + c0);
#pragma unroll
        for (int j = 0; j < 8; ++j) { const unsigned a = (va[j >> 1] >> (16 * (j & 1))) & 0xffffu, b = (vb[j >> 1] >> (16 * (j & 1))) & 0xffffu;
            *(LAS unsigned*)(Vt + (c0 + j) * LDP + 2 * lane) = a | (b << 16); } }
}
__device__ __forceinline__ void ret_a_item(const Args a, int item, LAS unsigned char* lds, int tid, int wave, int lane, int dry) {
    const bf16_t* PA = (const bf16_t*)(a.ws + WS_PA); const float* CS = (const float*)(a.ws + WS_CS); bf16_t* RS = (bf16_t*)(a.ws + WS_RS);
    const int b = item >> 6, h = (item >> 4) & 3, n = item & 15;
    LAS bf16_t* Kw = (LAS bf16_t*)lds; LAS bf16_t* Vn = Kw + 128 * LDP;
    const size_t row0 = (size_t)b * SEQ + n * 128;
    const float lg = log2f(1.0f - exp2f(-5.0f - (float)h));
    __syncthreads();
#pragma unroll
    for (int r = 0; r < 4; ++r) { const int idx = tid + 512 * r, tok = idx >> 4, c = idx & 15;
        const float w = exp2f((float)(127 - tok) * lg);
        const u32x4 kv = *(const u32x4*)(PA + (row0 + tok) * NA + PA_K + 128 * h + 8 * c);
        u32x4 o; o.x = pk2(bflo(kv.x) * w, bfhi(kv.x) * w); o.y = pk2(bflo(kv.y) * w, bfhi(kv.y) * w); o.z = pk2(bflo(kv.z) * w, bfhi(kv.z) * w); o.w = pk2(bflo(kv.w) * w, bfhi(kv.w) * w);
        *(LAS u32x4*)(Kw + tok * LDP + 8 * c) = o; }
    ret_stage_vn(PA, row0, h, Vn, tid);
    __syncthreads();
    const int fr = lane & 15, fq = lane >> 4;
    bf16x8 Af[4];
#pragma unroll
    for (int ks = 0; ks < 4; ++ks) Af[ks] = frag_tr2(Kw, LDP, 32 * ks + 8 * fq, 32 * ks + 8 * fq + 4, 16 * wave, lane);
    bf16_t* outp = RS + (size_t)item * 16384;
#pragma unroll
    for (int eb = 0; eb < 8; ++eb) { f32x4 acc = (f32x4){0.f, 0.f, 0.f, 0.f};
#pragma unroll
        for (int ks = 0; ks < 4; ++ks) acc = mfma16(Af[ks], frag_tr2(Vn, LDP, 32 * ks + 8 * fq, 32 * ks + 8 * fq + 4, 16 * eb, lane), acc);
        u32x2 o; o.x = pk2(acc[0], acc[1]); o.y = pk2(acc[2], acc[3]);
        if (!dry) *(u32x2*)(outp + (16 * eb + fr) * 128 + 16 * wave + 4 * fq) = o; }
}
__device__ __forceinline__ void ret_scan(const Args a, int gtid, int gthreads, int dry) {
    bf16_t* RS = (bf16_t*)(a.ws + WS_RS);
    for (int idx = gtid; idx < 32 * 4096; idx += gthreads) { const int bh = idx >> 12, unit = idx & 4095, h = bh & 3;
        const float cd = exp2f(128.0f * log2f(1.0f - exp2f(-5.0f - (float)h)));
        u32x2* p = (u32x2*)(RS + (size_t)bh * 16 * 16384 + unit * 4);
        u32x2 v[16];
#pragma unroll
        for (int n = 0; n < 16; ++n) v[n] = p[(size_t)n * 4096];
        float s0 = 0.f, s1 = 0.f, s2 = 0.f, s3 = 0.f;
#pragma unroll
        for (int n = 0; n < 16; ++n) { u32x2 o; o.x = pk2(s0, s1); o.y = pk2(s2, s3); if (!dry) p[(size_t)n * 4096] = o;
            s0 = cd * s0 + bflo(v[n].x); s1 = cd * s1 + bfhi(v[n].x); s2 = cd * s2 + bflo(v[n].y); s3 = cd * s3 + bfhi(v[n].y); } }
}
__device__ __attribute__((noinline)) void retb_stage(const Args a, int item, LAS unsigned char* lds, int tid, int wave, int lane) {
    item = __builtin_amdgcn_readfirstlane(item); wave = __builtin_amdgcn_readfirstlane(wave);
    const bf16_t* PA = (const bf16_t*)(a.ws + WS_PA); const float* CS = (const float*)(a.ws + WS_CS); const bf16_t* RS = (const bf16_t*)(a.ws + WS_RS);
    const int b = item >> 6, h = (item >> 4) & 3, n = item & 15;
    LAS bf16_t* Kn = (LAS bf16_t*)lds; LAS bf16_t* Vt = Kn + 128 * LDP; LAS bf16_t* St = Vt + 128 * LDP;
    const size_t row0 = (size_t)b * SEQ + n * 128;
    __syncthreads();
#pragma unroll
    for (int r = 0; r < 4; ++r) { const int idx = tid + 512 * r, tok = idx >> 4, c = idx & 15;
        *(LAS u32x4*)(Kn + tok * LDP + 8 * c) = *(const u32x4*)(PA + (row0 + tok) * NA + PA_K + 128 * h + 8 * c); }
    ret_stage_vn(PA, row0, h, Vt, tid); asm volatile("" ::: "memory");
    { const bf16_t* sp = RS + (size_t)item * 16384;
#pragma unroll
      for (int r = 0; r < 4; ++r) { const int idx = tid + 512 * r, e = idx >> 4, c = idx & 15; *(LAS u32x4*)(St + e * LDP + 8 * c) = *(const u32x4*)(sp + e * 128 + 8 * c); } }
    __syncthreads();
}
__device__ __attribute__((noinline)) void retb_compute(const Args a, int item, LAS unsigned char* lds, int tid, int wave, int lane, int dry) {
    dry = __builtin_amdgcn_readfirstlane(dry);
    item = __builtin_amdgcn_readfirstlane(item); wave = __builtin_amdgcn_readfirstlane(wave);
    bf16_t* PA = (bf16_t*)(a.ws + WS_PA); const float* CS = (const float*)(a.ws + WS_CS);
    const int b = item >> 6, h = (item >> 4) & 3, n = item & 15;
    const LAS bf16_t* Kn = (const LAS bf16_t*)lds; const LAS bf16_t* Vt = Kn + 128 * LDP; const LAS bf16_t* St = Vt + 128 * LDP;
    const size_t row0 = (size_t)b * SEQ + n * 128;
    const float lg = log2f(1.0f - exp2f(-5.0f - (float)h));
    const int fr = lane & 15, fq = lane >> 4;
    const int iq = 16 * wave + fr; const size_t rowq = row0 + iq;
    u32x4 Qf[4];
#pragma unroll
    for (int ks = 0; ks < 4; ++ks) Qf[ks] = *(const u32x4*)(PA + rowq * NA + PA_Q + 128 * h + 32 * ks + 8 * fq);
    bf16_t* gp = PA + rowq * NA + PA_G + 128 * h + 4 * fq;
    u32x2 gv[8];
#pragma unroll
    for (int eb = 0; eb < 8; ++eb) gv[eb] = *(const u32x2*)(gp + 16 * eb);
    u32x4 P[4];
#pragma unroll
    for (int kk = 0; kk < 4; ++kk) P[kk] = (u32x4){0u, 0u, 0u, 0u};
#pragma unroll
    for (int jb = 0; jb < 8; ++jb) {
        if (jb <= wave) { f32x4 acc = (f32x4){0.f, 0.f, 0.f, 0.f};
#pragma unroll
            for (int ks = 0; ks < 4; ++ks) acc = mfma16(*(const LAS bf16x8*)(Kn + (16 * jb + fr) * LDP + 32 * ks + 8 * fq), as_frag(Qf[ks]), acc);
            float v[4];
#pragma unroll
            for (int r = 0; r < 4; ++r) { const int dij = iq - (16 * jb + 4 * fq + r); v[r] = dij >= 0 ? acc[r] * exp2f((float)dij * lg) : 0.f; }
            P[jb >> 1][(jb & 1) * 2] = pk2(v[0], v[1]); P[jb >> 1][(jb & 1) * 2 + 1] = pk2(v[2], v[3]); }
        asm volatile("" ::: "memory"); }
    { const float gi = exp2f((float)(iq + 1) * lg);
#pragma unroll
      for (int ks = 0; ks < 4; ++ks)
#pragma unroll
          for (int jj = 0; jj < 4; ++jj) Qf[ks][jj] = pk2(bflo(Qf[ks][jj]) * gi, bfhi(Qf[ks][jj]) * gi); }
    const int nkk = (wave + 2) >> 1;
    f32x4 o[8]; float s1 = 0.f;
#pragma unroll
    for (int eb = 0; eb < 8; ++eb) { f32x4 acc = (f32x4){0.f, 0.f, 0.f, 0.f};
#pragma unroll
        for (int ks = 0; ks < 4; ++ks) acc = mfma16(*(const LAS bf16x8*)(St + (16 * eb + fr) * LDP + 32 * ks + 8 * fq), as_frag(Qf[ks]), acc);
#pragma unroll
        for (int kk = 0; kk < 4; ++kk) if (kk < nkk) acc = mfma16(frag_tr2(Vt, LDP, 32 * kk + 4 * fq, 32 * kk + 16 + 4 * fq, 16 * eb, lane), as_frag(P[kk]), acc);
        o[eb] = acc; s1 += (acc[0] + acc[1]) + (acc[2] + acc[3]); asm volatile("" ::: "memory"); }
    s1 += xor16(s1); s1 += xor32(s1, lane);
    const float mean = s1 * (1.0f / 128.0f); float s2 = 0.f;
#pragma unroll
    for (int eb = 0; eb < 8; ++eb) { const f32x4 d = o[eb] - mean; s2 += (d[0] * d[0] + d[1] * d[1]) + (d[2] * d[2] + d[3] * d[3]); }
    s2 += xor16(s2); s2 += xor32(s2, lane);
    const float rstd = 1.0f / sqrtf(s2 * (1.0f / 128.0f) + EPS);
#pragma unroll
    for (int eb = 0; eb < 8; ++eb) { const u32x2 g = gv[eb];
        const float y0 = (o[eb][0] - mean) * rstd * silu_f(bflo(g.x)), y1 = (o[eb][1] - mean) * rstd * silu_f(bfhi(g.x));
        const float y2 = (o[eb][2] - mean) * rstd * silu_f(bflo(g.y)), y3 = (o[eb][3] - mean) * rstd * silu_f(bfhi(g.y));
        u32x2 w; w.x = pk2(y0, y1); w.y = pk2(y2, y3); if (!dry) *(u32x2*)(gp + 16 * eb) = w; asm volatile("" ::: "memory"); }
}

constexpr int SSD_T0 = 105472, SSD_T1 = 109568, SSD_WT = 113664, SSD_SSQ = 129024, SSD_XW = 34816, SSD_RAW = 69632, SSD_XH = 69632, SSD_HH = 88064, XHP = 72;
__device__ __forceinline__ void ssd_stage_wtab(const float* cw, const float* cb, int g, LAS unsigned char* lds, int tid) {
    LAS float* wt = (LAS float*)(lds + SSD_WT);
    for (int i = tid; i < 5 * 768; i += 512) { const int k = i / 768, ci = i - 768 * k; const int ch = ci < 512 ? 512 * g + ci : (ci < 640 ? 1024 + 128 * g + (ci - 512) : 1280 + 128 * g + (ci - 640));
        wt[i] = k < 4 ? cw[k * 1536 + ch] : cb[ch]; }
}
template <int MODE>
__device__ __forceinline__ void ssd_tables(const Args a, int l, int b, int c, int g, LAS unsigned char* lds, int wave, int lane) {
    const float* DT = (const float*)(a.ws + WS_DT);
    LAS float* cst = (LAS float*)(lds + SSD_T0); LAS float* t1 = (LAS float*)(lds + SSD_T1);
    const int head = 8 * g + wave; const size_t row0 = (size_t)b * SEQ + 128 * c;
    const float A = -__expf(a.f(I_A_LOG)[l * 16 + head]);
    const float dt0 = DT[(row0 + 2 * lane) * 16 + head], dt1 = DT[(row0 + 2 * lane + 1) * 16 + head];
    const float a0 = dt0 * A, a1 = dt1 * A, s = a0 + a1;
    float v = s;
#pragma unroll
    for (int d = 1; d < 64; d <<= 1) { const float t = __builtin_bit_cast(float, __builtin_amdgcn_ds_bpermute((lane - d) << 2, __builtin_bit_cast(int, v))); if (lane >= d) v += t; }
    const float ex = v - s, cs0 = ex + a0, cs1 = ex + s;
    const float total = __builtin_bit_cast(float, __builtin_amdgcn_readlane(__builtin_bit_cast(int, v), 63));
    cst[wave * 128 + 2 * lane] = cs0; cst[wave * 128 + 2 * lane + 1] = cs1;
    if (MODE == 0) { t1[wave * 128 + 2 * lane] = dt0 * __expf(total - cs0); t1[wave * 128 + 2 * lane + 1] = dt1 * __expf(total - cs1);
        if (lane == 0) ((float*)(a.ws + WS_CD))[((size_t)b * 16 + c) * 16 + head] = __expf(total); }
    else { t1[wave * 128 + 2 * lane] = dt0; t1[wave * 128 + 2 * lane + 1] = dt1; }
}
__device__ __attribute__((noinline)) void ssda_prep(const Args a, int l, int item, LAS unsigned char* lds, int tid, int wave, int lane) {
    item = __builtin_amdgcn_readfirstlane(item); wave = __builtin_amdgcn_readfirstlane(wave); l = __builtin_amdgcn_readfirstlane(l);
    const int b = item >> 5, c = (item >> 1) & 15, g = item & 1;
    __syncthreads();
    ssd_stage_wtab(a.f(I_CONV_W) + (size_t)l * 4 * 1536, a.f(I_CONV_B) + (size_t)l * 1536, g, lds, tid);
    ssd_tables<0>(a, l, b, c, g, lds, wave, lane);
}
__device__ __forceinline__ void ssda_rawload(const bf16_t* PA, const bf16_t* HB, size_t row0, int c, int chb, int tid, u32x4 (&rv)[5]) {
#pragma unroll
    for (int r = 0; r < 5; ++r) { const int idx = tid + 512 * r, rr = idx >> 4, cc = idx & 15; rv[r] = (u32x4){0u, 0u, 0u, 0u};
        if (rr < 131) { if (rr >= 3) rv[r] = *(const u32x4*)(PA + (row0 + rr - 3) * NA + PA_XBC + chb + 8 * cc);
            else if (c > 0) rv[r] = *(const u32x4*)(HB + (((row0 >> 7) - 1) * 3 + rr) * 1536 + chb + 8 * cc); } }
}
__device__ __attribute__((noinline)) void ssda_slabs(const Args a, int item, LAS unsigned char* lds, int tid, int wave, int lane, int dry) {
    dry = __builtin_amdgcn_readfirstlane(dry);
    item = __builtin_amdgcn_readfirstlane(item); wave = __builtin_amdgcn_readfirstlane(wave);
    const int b = item >> 5, c = (item >> 1) & 15, g = item & 1;
    bf16_t* PA = (bf16_t*)(a.ws + WS_PA); const bf16_t* HB = (const bf16_t*)(a.ws + WS_HB); bf16_t* SS = (bf16_t*)(a.ws + WS_SS);
    LAS bf16_t* Bn = (LAS bf16_t*)lds; LAS bf16_t* Xw = (LAS bf16_t*)(lds + SSD_XW); LAS bf16_t* Raw = (LAS bf16_t*)(lds + SSD_RAW);
    const LAS float* wt = (const LAS float*)(lds + SSD_T1); const LAS float* taps = (const LAS float*)(lds + SSD_WT);
    const size_t row0 = (size_t)b * SEQ + 128 * c;
    const int fr = lane & 15, fq = lane >> 4;
    u32x4 rv[5];
    ssda_rawload(PA, HB, row0, c, 1024 + 128 * g, tid, rv);
#pragma unroll 1
    for (int sl = 0; sl < 6; ++sl) {
        const int chb = sl == 0 ? 1024 + 128 * g : (sl == 1 ? 1280 + 128 * g : 512 * g + 128 * (sl - 2));
        const int cib = sl == 0 ? 512 : (sl == 1 ? 640 : 128 * (sl - 2));
        __syncthreads();
#pragma unroll
        for (int r = 0; r < 5; ++r) { const int idx = tid + 512 * r; if ((idx >> 4) < 131) *(LAS u32x4*)(Raw + (idx >> 4) * LDP + 8 * (idx & 15)) = rv[r]; }
        __syncthreads();
        if (sl < 5) { const int nsl = sl + 1; ssda_rawload(PA, HB, row0, c, nsl == 1 ? 1280 + 128 * g : 512 * g + 128 * (nsl - 2), tid, rv); }
        { const int t0 = 4 * (tid >> 4);
#pragma unroll 1
          for (int hf = 0; hf < 2; ++hf) { const int c4 = 2 * (tid & 15) + hf;
            const LAS float* tp = taps + cib + 4 * c4;
            f32x4 tw[5];
#pragma unroll
            for (int k = 0; k < 5; ++k) tw[k] = *(const LAS f32x4*)(tp + k * 768);
            f32x4 o[4];
#pragma unroll
            for (int q = 0; q < 4; ++q) o[q] = tw[4];
#pragma unroll
            for (int rr = 0; rr < 7; ++rr) { const u32x2 xr = *(const LAS u32x2*)(Raw + (t0 + rr) * LDP + 4 * c4);
                const f32x4 xf = (f32x4){bflo(xr.x), bfhi(xr.x), bflo(xr.y), bfhi(xr.y)};
#pragma unroll
                for (int q = 0; q < 4; ++q) { const int k = rr - q; if (k >= 0 && k < 4) o[q] += tw[k] * xf; } }
            const float wsel = sl >= 2 ? 1.f : 0.f; (void)wsel;
#pragma unroll
            for (int q = 0; q < 4; ++q) { const int tok = t0 + q;
#pragma unroll
                for (int j = 0; j < 4; ++j) o[q][j] = silu_f(o[q][j]);
                u32x2 pv; pv.x = pk2(o[q][0], o[q][1]); pv.y = pk2(o[q][2], o[q][3]);
                if (!dry) *(u32x2*)(PA + (row0 + tok) * NA + PA_XBC + chb + 4 * c4) = pv;
                if (sl == 0) *(LAS u32x2*)(Bn + tok * LDP + 4 * c4) = pv;
                if (sl >= 2) { const float w = wt[(2 * (sl - 2) + (c4 >> 4)) * 128 + tok];
                    u32x2 pw; pw.x = pk2(o[q][0] * w, o[q][1] * w); pw.y = pk2(o[q][2] * w, o[q][3] * w);
                    *(LAS u32x2*)(Xw + tok * LDP + 4 * c4) = pw; } } } }
        if (sl >= 2) {
            __syncthreads();
            bf16x8 Bf[4];
#pragma unroll
            for (int ks = 0; ks < 4; ++ks) Bf[ks] = frag_tr2(Xw, LDP, 32 * ks + 8 * fq, 32 * ks + 8 * fq + 4, 16 * wave, lane);
            const int head = 8 * g + 2 * (sl - 2) + (wave >> 2);
            bf16_t* outp = SS + (((size_t)b * 16 + c) * 16 + head) * 8192 + (16 * (wave & 3) + fr) * 128 + 4 * fq;
#pragma unroll 2
            for (int nb = 0; nb < 8; ++nb) { f32x4 acc = (f32x4){0.f, 0.f, 0.f, 0.f};
#pragma unroll
                for (int ks = 0; ks < 4; ++ks) acc = mfma16(frag_tr2(Bn, LDP, 32 * ks + 8 * fq, 32 * ks + 8 * fq + 4, 16 * nb, lane), Bf[ks], acc);
                u32x2 o; o.x = pk2(acc[0], acc[1]); o.y = pk2(acc[2], acc[3]);
                if (!dry) *(u32x2*)(outp + 16 * nb) = o; } }
    }
}
__device__ __forceinline__ void ssd_scan(const Args a, int gtid, int gthreads, int dry) {
    bf16_t* SS = (bf16_t*)(a.ws + WS_SS); const float* CD = (const float*)(a.ws + WS_CD);
    for (int idx = gtid; idx < 8 * 16 * 2048; idx += gthreads) { const int bb = idx >> 15, head = (idx >> 11) & 15, unit = idx & 2047;
        u32x2* p = (u32x2*)(SS + ((size_t)bb * 256 + head) * 8192 + unit * 4);
        const float* cdp = CD + (size_t)bb * 256 + head;
        u32x2 v[16]; float cd[16];
#pragma unroll
        for (int c = 0; c < 16; ++c) { v[c] = p[(size_t)c * 16 * 2048]; cd[c] = cdp[c * 16]; }
        float s0 = 0.f, s1 = 0.f, s2 = 0.f, s3 = 0.f;
#pragma unroll
        for (int c = 0; c < 16; ++c) { u32x2 o; o.x = pk2(s0, s1); o.y = pk2(s2, s3); if (!dry) p[(size_t)c * 16 * 2048] = o;
            s0 = cd[c] * s0 + bflo(v[c].x); s1 = cd[c] * s1 + bfhi(v[c].x); s2 = cd[c] * s2 + bflo(v[c].y); s3 = cd[c] * s3 + bfhi(v[c].y); } }
}
__device__ __attribute__((noinline)) void ssdb_prep(const Args a, int l, int item, LAS unsigned char* lds, int tid, int wave, int lane) {
    item = __builtin_amdgcn_readfirstlane(item); wave = __builtin_amdgcn_readfirstlane(wave); l = __builtin_amdgcn_readfirstlane(l);
    const int b = item >> 5, c = (item >> 1) & 15, g = item & 1;
    const bf16_t* PA = (const bf16_t*)(a.ws + WS_PA);
    LAS bf16_t* Bn = (LAS bf16_t*)lds;
    const size_t row0 = (size_t)b * SEQ + 128 * c;
    u32x4 cv[8];
#pragma unroll
    for (int r = 0; r < 8; ++r) { const int idx = tid + 512 * r, which = idx >> 11, tok = (idx >> 4) & 127, cc = idx & 15;
        cv[r] = *(const u32x4*)(PA + (row0 + tok) * NA + PA_XBC + 1024 + 256 * which + 128 * g + 8 * cc); }
    const float dsk = tid < 8 ? a.f(I_SSM_D)[l * 16 + 8 * g + tid] : 0.f;
    __syncthreads();
    ssd_tables<1>(a, l, b, c, g, lds, wave, lane);
    if (tid < 8) ((LAS float*)(lds + SSD_SSQ + 512))[tid] = dsk;
#pragma unroll
    for (int r = 0; r < 8; ++r) { const int idx = tid + 512 * r, which = idx >> 11, tok = (idx >> 4) & 127, cc = idx & 15;
        *(LAS u32x4*)(Bn + (which * 128 + tok) * LDP + 8 * cc) = cv[r]; }
}
__device__ __attribute__((noinline)) void ssdb_gt(LAS unsigned char* lds, int tid, int wave, int lane) {
    wave = __builtin_amdgcn_readfirstlane(wave);
    const LAS bf16_t* Bn = (const LAS bf16_t*)lds; const LAS bf16_t* Cn = Bn + 128 * LDP;
    const int fr = lane & 15, fq = lane >> 4;
    __syncthreads();
    u32x2 GT[8];
    bf16x8 Cf[4];
#pragma unroll
    for (int ks = 0; ks < 4; ++ks) Cf[ks] = *(const LAS bf16x8*)(Cn + (16 * wave + fr) * LDP + 32 * ks + 8 * fq);
#pragma unroll
    for (int sb = 0; sb < 8; ++sb) { f32x4 acc = (f32x4){0.f, 0.f, 0.f, 0.f};
        if (sb <= wave) {
#pragma unroll
            for (int ks = 0; ks < 4; ++ks) acc = mfma16(*(const LAS bf16x8*)(Bn + (16 * sb + fr) * LDP + 32 * ks + 8 * fq), Cf[ks], acc); }
        GT[sb].x = pk2(acc[0], acc[1]); GT[sb].y = pk2(acc[2], acc[3]); }
    __syncthreads();
#pragma unroll
    for (int sb = 0; sb < 8; ++sb) *(LAS u32x2*)(lds + (sb * 512 + tid) * 8) = GT[sb];
}
__device__ __attribute__((noinline)) void ssdb_heads(const Args a, int l, int item, LAS unsigned char* lds, int tid, int wave, int lane, int dry) {
    dry = __builtin_amdgcn_readfirstlane(dry);
    item = __builtin_amdgcn_readfirstlane(item); wave = __builtin_amdgcn_readfirstlane(wave);
    const int b = item >> 5, c = (item >> 1) & 15, g = item & 1;
    bf16_t* PA = (bf16_t*)(a.ws + WS_PA); const bf16_t* SS = (const bf16_t*)(a.ws + WS_SS); float* SSQ = (float*)(a.ws + WS_SSQ);
    const LAS bf16_t* Cn = (const LAS bf16_t*)lds + 128 * LDP; LAS bf16_t* xh = (LAS bf16_t*)(lds + SSD_XH); LAS bf16_t* Hh = (LAS bf16_t*)(lds + SSD_HH);
    const LAS float* cst = (const LAS float*)(lds + SSD_T0); const LAS float* dtt = (const LAS float*)(lds + SSD_T1);
    const size_t row0 = (size_t)b * SEQ + 128 * c;
    const int fr = lane & 15, fq = lane >> 4, lcol = 16 * wave + fr; const size_t rowl = row0 + lcol;
    const bf16_t* xsrc0 = PA + (row0 + (tid >> 3)) * NA + PA_XBC + 64 * 8 * g + 8 * (tid & 7); const bf16_t* xsrc1 = xsrc0 + (size_t)64 * NA;
    const bf16_t* hsrc = SS + (((size_t)b * 16 + c) * 16 + 8 * g) * 8192 + (tid >> 4) * 128 + 8 * (tid & 15);
    bf16_t* zp = PA + rowl * NA + PA_Z + 64 * 8 * g + 4 * fq;
    u32x4 gx0 = *(const u32x4*)xsrc0, gx1 = *(const u32x4*)xsrc1, gh0 = *(const u32x4*)hsrc, gh1 = *(const u32x4*)(hsrc + 32 * 128);
    u32x2 zv[4];
#pragma unroll
    for (int pb = 0; pb < 4; ++pb) zv[pb] = *(const u32x2*)(zp + 16 * pb);
    float ssq_acc = 0.f;
    __syncthreads();
    bf16x8 Cf[4];
#pragma unroll
    for (int ks = 0; ks < 4; ++ks) Cf[ks] = *(const LAS bf16x8*)(Cn + lcol * LDP + 32 * ks + 8 * fq);
#pragma unroll 1
    for (int hh = 0; hh < 8; ++hh) {
        int wv = wave; asm volatile("" : "+s"(wv));
        const int nkk = (wv + 2) >> 1;
        int fd = fr; asm volatile("" : "+v"(fd));
        __syncthreads();
        *(LAS u32x4*)(xh + (tid >> 3) * XHP + 8 * (tid & 7)) = gx0; *(LAS u32x4*)(xh + (64 + (tid >> 3)) * XHP + 8 * (tid & 7)) = gx1;
        *(LAS u32x4*)(Hh + (tid >> 4) * LDP + 8 * (tid & 15)) = gh0; *(LAS u32x4*)(Hh + (32 + (tid >> 4)) * LDP + 8 * (tid & 15)) = gh1;
        __syncthreads();
        if (hh < 7) {
            gx0 = *(const u32x4*)(xsrc0 + 64 * (hh + 1)); gx1 = *(const u32x4*)(xsrc1 + 64 * (hh + 1)); gh0 = *(const u32x4*)(hsrc + (size_t)(hh + 1) * 8192); gh1 = *(const u32x4*)(hsrc + (size_t)(hh + 1) * 8192 + 32 * 128); }
        const float csl = cst[hh * 128 + lcol], ecl = __expf(csl), Dh = ((const LAS float*)(lds + SSD_SSQ + 512))[hh];
        u32x4 Pm[4];
#pragma unroll
        for (int kk = 0; kk < 4; ++kk) Pm[kk] = (u32x4){0u, 0u, 0u, 0u};
#pragma unroll
        for (int sb = 0; sb < 8; ++sb) {
            if (sb <= wv) { const f32x4 cs4 = *(const LAS f32x4*)(cst + hh * 128 + 16 * sb + 4 * fq), dt4 = *(const LAS f32x4*)(dtt + hh * 128 + 16 * sb + 4 * fq);
                const u32x2 gp = *(const LAS u32x2*)(lds + (sb * 512 + tid) * 8);
                const float gt[4] = {bflo(gp.x), bfhi(gp.x), bflo(gp.y), bfhi(gp.y)};
                float v[4];
#pragma unroll
                for (int r = 0; r < 4; ++r) { const bool keep = sb < wv || 4 * fq + r <= fd;
                    v[r] = keep ? gt[r] * __expf(csl - cs4[r]) * dt4[r] : 0.f; }
                Pm[sb >> 1][(sb & 1) * 2] = pk2(v[0], v[1]); Pm[sb >> 1][(sb & 1) * 2 + 1] = pk2(v[2], v[3]); }
            asm volatile("" ::: "memory"); }
        float ssq = 0.f;
#pragma unroll
        for (int pb = 0; pb < 4; ++pb) { f32x4 yd = (f32x4){0.f, 0.f, 0.f, 0.f}, yo = (f32x4){0.f, 0.f, 0.f, 0.f};
#pragma unroll
            for (int kk = 0; kk < 4; ++kk) if (kk < nkk) yd = mfma16(frag_tr2(xh, XHP, 32 * kk + 4 * fq, 32 * kk + 16 + 4 * fq, 16 * pb, lane), as_frag(Pm[kk]), yd);
#pragma unroll
            for (int ks = 0; ks < 4; ++ks) yo = mfma16(*(const LAS bf16x8*)(Hh + (16 * pb + fr) * LDP + 32 * ks + 8 * fq), Cf[ks], yo);
            const u32x2 z = zv[pb], xv = *(const LAS u32x2*)(xh + lcol * XHP + 16 * pb + 4 * fq);
            float y[4];
            y[0] = (yd[0] + ecl * yo[0] + Dh * bflo(xv.x)) * silu_f(bflo(z.x)); y[1] = (yd[1] + ecl * yo[1] + Dh * bfhi(xv.x)) * silu_f(bfhi(z.x));
            y[2] = (yd[2] + ecl * yo[2] + Dh * bflo(xv.y)) * silu_f(bflo(z.y)); y[3] = (yd[3] + ecl * yo[3] + Dh * bfhi(xv.y)) * silu_f(bfhi(z.y));
            ssq += (y[0] * y[0] + y[1] * y[1]) + (y[2] * y[2] + y[3] * y[3]);
            u32x2 w; w.x = pk2(y[0], y[1]); w.y = pk2(y[2], y[3]); if (!dry) *(u32x2*)(zp + 64 * hh + 16 * pb) = w;
            asm volatile("" ::: "memory"); }
        ssq += xor16(ssq); ssq += xor32(ssq, lane);
        ssq_acc += ssq;
        if (hh < 7) {
#pragma unroll
            for (int pb = 0; pb < 4; ++pb) zv[pb] = *(const u32x2*)(zp + 64 * (hh + 1) + 16 * pb); }
    }
    if (fq == 0 && !dry) SSQ[rowl * 2 + g] = ssq_acc;
}
__device__ __attribute__((noinline)) void phase_mix_a(const Args a, int l, LAS unsigned char* lds, int bid, int nblk, int tid, int wave, int lane, int dry) {
    dry = __builtin_amdgcn_readfirstlane(dry);
    bid = __builtin_amdgcn_readfirstlane(bid); nblk = __builtin_amdgcn_readfirstlane(nblk); wave = __builtin_amdgcn_readfirstlane(wave);
    for (int item = bid; item < 512; item += nblk) ret_a_item(a, item, lds, tid, wave, lane, dry);
}
__device__ __attribute__((noinline)) void phase_mix_scan(const Args a, int l, LAS unsigned char* lds, int bid, int nblk, int tid, int wave, int lane, int dry) {
    dry = __builtin_amdgcn_readfirstlane(dry);
    ret_scan(a, bid * 512 + tid, nblk * 512, dry);
    ssd_scan(a, bid * 512 + tid, nblk * 512, dry);
}
__device__ __attribute__((noinline)) void phase_final(const Args a, int bid, int nblk, int wave, int lane) {
    const int gw = bid * 8 + wave, NGW = nblk * 8;
    for (int tok = gw; tok < T; tok += NGW) {
        f32x4* xr = (f32x4*)(a.out + (size_t)tok * D) + lane;
        f32x4 v[4]; float s = 0.f;
#pragma unroll
        for (int j = 0; j < 4; ++j) { v[j] = xr[64 * j]; s += (v[j][0] * v[j][0] + v[j][1] * v[j][1]) + (v[j][2] * v[j][2] + v[j][3] * v[j][3]); }
        const float rstd = 1.0f / sqrtf(wave_sum(s) * (1.0f / D) + EPS);
#pragma unroll
        for (int j = 0; j < 4; ++j) { const f32x4 g = *(const f32x4*)(a.f(I_FINAL_G) + 4 * lane + 256 * j); xr[64 * j] = (v[j] * rstd) * g; }
    }
}

__device__ __attribute__((noinline)) void rstd_rows(const Args a, int gtid, int gthreads) {
    float* sq = (float*)(a.ws + WS_SSQ);
    for (int row = gtid; row < T; row += gthreads) sq[2 * T + row] = 1.0f / sqrtf((sq[2 * row] + sq[2 * row + 1]) * (1.0f / 1024.0f) + EPS);
}
constexpr int NPHASE = 13;
__global__ void __launch_bounds__(512, 2) mk_fwd(KArgs ka) {
    extern __shared__ __attribute__((aligned(16))) unsigned char lds_raw[];
    LAS unsigned char* lds = (LAS unsigned char*)lds_raw;
    const int tid0 = threadIdx.x, wave = __builtin_amdgcn_readfirstlane(tid0 >> 6);
    const int bid = blockIdx.x, nblk = gridDim.x;
    volatile LAS unsigned* MISC = (volatile LAS unsigned*)(lds + MISC_OFF);
    for (int u = tid0; u < (LDS_BYTES - RING_BYTES) / 4; u += 512) ((LAS unsigned*)(lds + RING_BYTES))[u] = 0u;
    __syncthreads();
    if (tid0 == 0) {
#pragma unroll
        for (int i = 0; i < 19; ++i) { const unsigned long long v = (unsigned long long)ka.in[i]; ((LAS unsigned*)(lds + ARGS_OFF))[2 * i] = (unsigned)v; ((LAS unsigned*)(lds + ARGS_OFF))[2 * i + 1] = (unsigned)(v >> 32); } }
    __syncthreads();
    unsigned* ctl = (unsigned*)(ka.ws + WS_CTL);
    XcdBarrier bar; bar.bar = ctl + CW_BAR; bar.x = 0; bar.st = nullptr;
    if (!MK_SPLIT) bar = xcd_barrier_post(ctl + CW_BAR, MISC + 8);
    const int lo = ka.ph_lo, hi = ka.ph_hi;
    const int rep_ph = ka.rep_ph, rep_n = ka.rep_ph >= 0 ? ka.rep_n : 0, sub = ka.sub;
#pragma unroll 1
    for (int it = lo; it < hi + rep_n; ++it) {
        const int ph = (rep_ph < 0 || it <= rep_ph) ? it : (it - rep_n > rep_ph ? it - rep_n : rep_ph);
        int tid = tid0; asm volatile("" : "+v"(tid)); const int lane = tid & 63;
        const int dry = (rep_ph >= 0 && it > rep_ph && it <= rep_ph + rep_n) ? 1 : 0;
        Args a; a.lds = lds; a.out = ka.out; a.ws = ka.ws; asm volatile("" : "+s"(a.ws), "+s"(a.out));
        bf16_t* PA = (bf16_t*)(a.ws + WS_PA); bf16_t* H = (bf16_t*)(a.ws + WS_H);
        const bf16_t* WinT = (const bf16_t*)(a.ws + WS_WIN); const bf16_t* WbrT = (const bf16_t*)(a.ws + WS_WBR); const bf16_t* WoutT = (const bf16_t*)(a.ws + WS_WOUT);
        const int l = ph >= 7 ? 1 : 0, k = ph - 1 - 6 * l;
        const float* xcur = l == 0 ? a.f(I_X) : a.out;
        if (ph == 0) { phase_p0(a, lds, bid, nblk, tid, wave, lane); __syncthreads(); convert_weights(a, 0, lds, bid * 8 + wave, nblk * 8, wave, lane); }
        else if (k == 0) { if (l > 0) convert_weights(a, l, lds, bid * 8 + wave, nblk * 8, wave, lane); phase_hprep(a, l, xcur, lds, bid, nblk, tid, wave, lane); }
        else if (k == 1) { pg8::Gemm g{H, 1024, WinT, T, N1A, 1024}; pg8::StaticOrder S; S.init(T, N1A, nblk, bid); EpiIn1 E{PA, (bf16_t*)(a.ws + WS_HB), (const float*)(a.ws + WS_CS)}; pg8::gemm_phase(lds, g, S, E, pg8::AMapLinear{}); }
        else if (k == 2) { if (!dry || (sub & 8)) phase_mix_a(a, l, lds, bid, nblk, tid, wave, lane, dry);
            if (!dry || (sub & 16)) for (int item = bid; item < 256; item += nblk) { ssda_prep(a, l, item, lds, tid, wave, lane); ssda_slabs(a, item, lds, tid, wave, lane, dry); } }
        else if (k == 3) { phase_mix_scan(a, l, lds, bid, nblk, tid, wave, lane, dry); }
        else if (k == 4) {
            if (!dry || (sub & 1)) sc_items(a, l, bid, nblk, tid, dry);
            if (!dry || (sub & 2)) for (int item = bid; item < 512; item += nblk) { retb_stage(a, item, lds, tid, wave, lane); retb_compute(a, item, lds, tid, wave, lane, dry); }
            if (!dry || (sub & 4)) for (int item = bid; item < 256; item += nblk) { ssdb_prep(a, l, item, lds, tid, wave, lane); ssdb_gt(lds, tid, wave, lane);
                ssdb_heads(a, l, item, lds, tid, wave, lane, dry); } }
        else if (k == 5) {
            pg8::StaticOrder S2; S2.init(T, 1024, nblk, bid); pg8::Unit u2;
            bf16_t* MGb = (bf16_t*)(a.ws + WS_RS);
            if (S2.next(0, u2)) {
                { pg8::Gemm g{H, 1024, WinT + (size_t)N1A * 1024, T, N1B, 1024}; pg8::GateOrder S{u2.pm, u2.pn}; EpiIn2 E{PA, (const float*)(a.ws + WS_SSQ)}; pg8::gemm_phase(lds, g, S, E, pg8::AMapLinear{}); }
                { pg8::Gemm g{PA, NA, WbrT, T, 1024, 2048}; EpiMerge E{PA, MGb}; pg8::gemm_phase(lds, g, S2, E, pg8::AMapBranch{}); }
                unsigned* cnt = ctl + CW_SEAM + l * 4096 + 64 * u2.pm;
                if (tid == 0) __hip_atomic_fetch_add(cnt, 1u, __ATOMIC_RELAXED, __HIP_MEMORY_SCOPE_AGENT);
                if (tid < 64) { unsigned sp = 0;
                    while ((unsigned)__builtin_amdgcn_readfirstlane(__hip_atomic_load(cnt, __ATOMIC_RELAXED, __HIP_MEMORY_SCOPE_AGENT)) < 4u) { __builtin_amdgcn_s_sleep(2); if (++sp > (1u << 22)) break; }
                    __builtin_amdgcn_fence(__ATOMIC_ACQUIRE, "agent"); asm volatile("s_waitcnt vmcnt(0)" ::: "memory"); }
                __syncthreads();
                { pg8::Gemm g{MGb, 1024, WoutT, T, 1024, 1024}; const float* rgp = (const float*)(a.ws + WS_ADA) + (size_t)l * 8 * 3072 + 2048;
                  if (l + 1 < DEPTH) { EpiOut E{xcur, a.out, rgp}; pg8::gemm_phase(lds, g, S2, E, pg8::AMapLinear{}); }
                  else { EpiOutFinal E{xcur, a.out, rgp, a.f(I_FINAL_G), ctl}; pg8::gemm_phase(lds, g, S2, E, pg8::AMapLinear{}); } } } }
        if (!MK_SPLIT && it + 1 < hi + rep_n) xcd_barrier(bar);
    }
}

extern "C" void kernel_launch(void* const* d_in, const int* in_sizes, int n_in, void* d_out, int out_size, void* d_ws, size_t ws_size, hipStream_t stream) {
    static int grid = 0;
    if (grid == 0) {
        if (n_in != 19 || in_sizes[0] != T * D || out_size != T * D || ws_size < WS_END) { fprintf(stderr, "kernel_launch: unexpected shapes (n_in %d, in0 %d, out %d, ws %zu, need %zu)\n", n_in, n_in > 0 ? in_sizes[0] : -1, out_size, ws_size, (size_t)WS_END); grid = -1; return; }
        int dev = 0, cus = 0, per_cu = 0;
        if (hipGetDevice(&dev) != hipSuccess || hipDeviceGetAttribute(&cus, hipDeviceAttributeMultiprocessorCount, dev) != hipSuccess) { grid = -1; return; }
        if (hipFuncSetAttribute((const void*)mk_fwd, hipFuncAttributeMaxDynamicSharedMemorySize, LDS_BYTES) != hipSuccess) { fprintf(stderr, "kernel_launch: hipFuncSetAttribute failed\n"); grid = -1; return; }
        if (hipOccupancyMaxActiveBlocksPerMultiprocessor(&per_cu, (const void*)mk_fwd, 512, LDS_BYTES) != hipSuccess || per_cu < 1) { fprintf(stderr, "kernel_launch: occupancy query says %d blocks per CU\n", per_cu); }
        (void)hipGetLastError();
        grid = cus;
        if (grid != 256) fprintf(stderr, "kernel_launch: %d CUs (built for 256)\n", grid);
    }
    if (grid < 0) return;
    (void)hipMemsetAsync((char*)d_ws + WS_CTL, 0, CTL_BYTES, stream);
    KArgs a{};
    for (int i = 0; i < 19; ++i) a.in[i] = d_in[i];
    a.out = (float*)d_out; a.ws = (unsigned char*)d_ws;
#if MK_SPLIT
    for (int ph = 0; ph < NPHASE && ph < MK_PH_HI; ++ph) { a.ph_lo = ph; a.ph_hi = ph + 1; hipLaunchKernelGGL(mk_fwd, dim3(grid), dim3(512), LDS_BYTES, stream, a); }
#else
    a.ph_lo = 0; a.ph_hi = NPHASE; a.rep_ph = MK_REP_PH; a.rep_n = MK_REP_N; a.sub = MK_SUB;
    hipLaunchKernelGGL(mk_fwd, dim3(grid), dim3(512), LDS_BYTES, stream, a);
#endif
}
```
